# Optimizing an MI355X kernel written in HIP

```python
import math
import jax, jax.numpy as jnp
from jax import lax
import numpy as np

D_MODEL = 1024
BATCH = 2
SEQ = 8192
DEPTH = 1

D_MIX = D_MODEL
M_HEADS = 4
M_HEAD_DIM = 128
D_MLSTM = M_HEADS * M_HEAD_DIM
G_GROUPS = 4
G_DIM = 128
D_SGU = G_GROUPS * G_DIM
SGU_CHUNK = 128
MLSTM_CHUNK = 128
CONV_K = 4
D_FF = int(math.ceil((8 * D_MODEL / 3) / 256) * 256)
N_IN_COLS = 4 * D_MLSTM + 2 * M_HEADS + 2 * D_SGU
ALPHA = (2.0 * DEPTH) ** 0.25
BETA = (8.0 * DEPTH) ** -0.25
LN_EPS = 1e-5

kernel_name = "hybrid_mlstm_sgu_deepnorm_block"


def _layernorm(x, w, b):
    xf = x.astype(jnp.float32)
    mu = jnp.mean(xf, axis=-1, keepdims=True)
    var = jnp.mean(jnp.square(xf - mu), axis=-1, keepdims=True)
    y = (xf - mu) * lax.rsqrt(var + LN_EPS)
    return (y * w.astype(jnp.float32) + b.astype(jnp.float32)).astype(x.dtype)


def _causal_depthwise_conv(x, w):
    S = x.shape[1]
    xp = jnp.pad(x, ((0, 0), (CONV_K - 1, 0), (0, 0)))
    y = w[0] * xp[:, 0:S]
    for j in range(1, CONV_K):
        y = y + w[j] * xp[:, j:j + S]
    return y


def _mlstm_chunkwise(q, k, v, i_pre, f_pre):
    B, H, S, d = q.shape
    L = MLSTM_CHUNK
    nc = S // L
    q = q.astype(jnp.float32)
    k = k.astype(jnp.float32) * (d ** -0.5)
    v = v.astype(jnp.float32)
    log_i = i_pre.astype(jnp.float32)
    log_f = jax.nn.log_sigmoid(f_pre.astype(jnp.float32))

    def chunks(t):
        return jnp.moveaxis(t.reshape(B, H, nc, L, *t.shape[3:]), 2, 0)

    tril = jnp.tril(jnp.ones((L, L), dtype=bool))

    def step(carry, inp):
        C, n, m = carry
        qc, kc, vc, ic, fc = inp
        b = jnp.cumsum(fc, axis=-1)
        g = b[..., -1]
        dlog = b[..., :, None] - b[..., None, :] + ic[..., None, :]
        dlog = jnp.where(tril, dlog, -jnp.inf)
        inter = b + m[..., None]
        m_j = jnp.maximum(inter, jnp.max(dlog, axis=-1))
        w = jnp.exp(dlog - m_j[..., None])
        s = jnp.einsum('bhld,bhsd->bhls', qc, kc) * w
        a = jnp.exp(inter - m_j)
        num = (jnp.einsum('bhls,bhsd->bhld', s, vc)
               + a[..., None] * jnp.einsum('bhvk,bhlk->bhlv', C, qc))
        den = jnp.sum(s, axis=-1) + a * jnp.einsum('bhk,bhlk->bhl', n, qc)
        h = num / jnp.maximum(jnp.abs(den), jnp.exp(-m_j))[..., None]
        wlog = g[..., None] - b + ic
        m_new = jnp.maximum(g + m, jnp.max(wlog, axis=-1))
        ws = jnp.exp(wlog - m_new[..., None])
        decay = jnp.exp(g + m - m_new)
        C_new = decay[..., None, None] * C + jnp.einsum('bhl,bhlv,bhlk->bhvk', ws, vc, kc)
        n_new = decay[..., None] * n + jnp.einsum('bhl,bhlk->bhk', ws, kc)
        return (C_new, n_new, m_new), h

    init = (jnp.zeros((B, H, d, d), jnp.float32),
            jnp.zeros((B, H, d), jnp.float32),
            jnp.zeros((B, H), jnp.float32))
    _, hs = lax.scan(step, init, (chunks(q), chunks(k), chunks(v), chunks(log_i), chunks(log_f)))
    return jnp.moveaxis(hs, 0, 2).reshape(B, H, S, d)


def _hybrid_mixer(x, w_in, b_gates, conv_qk, mlstm_norm_w, sgu_norm_w, sgu_norm_b,
                  w_spatial, b_spatial, w_out):
    B, S, _ = x.shape
    p = jnp.einsum('bsd,dc->bsc', x, w_in)
    o0 = 0
    qk = p[..., o0:o0 + 2 * D_MLSTM]; o0 += 2 * D_MLSTM
    v = p[..., o0:o0 + D_MLSTM]; o0 += D_MLSTM
    o_gate = p[..., o0:o0 + D_MLSTM]; o0 += D_MLSTM
    gates = p[..., o0:o0 + 2 * M_HEADS] + b_gates; o0 += 2 * M_HEADS
    z = p[..., o0:o0 + 2 * D_SGU]

    qk = jax.nn.silu(_causal_depthwise_conv(qk, conv_qk))
    q, k = qk[..., :D_MLSTM], qk[..., D_MLSTM:]

    def heads(t):
        return t.reshape(B, S, M_HEADS, M_HEAD_DIM).transpose(0, 2, 1, 3)

    i_pre = gates[..., :M_HEADS].transpose(0, 2, 1)
    f_pre = gates[..., M_HEADS:].transpose(0, 2, 1)
    h = _mlstm_chunkwise(heads(q), heads(k), heads(v), i_pre, f_pre)
    h = h.transpose(0, 2, 1, 3)
    mu = jnp.mean(h, axis=-1, keepdims=True)
    var = jnp.mean(jnp.square(h - mu), axis=-1, keepdims=True)
    h = ((h - mu) * lax.rsqrt(var + LN_EPS)).reshape(B, S, D_MLSTM)
    h = (h * mlstm_norm_w.astype(jnp.float32)).astype(x.dtype)
    y_m = jax.nn.sigmoid(o_gate) * h

    z = jax.nn.gelu(z, approximate=False)
    u, vs = z[..., :D_SGU], z[..., D_SGU:]
    vs = vs.reshape(B, S, G_GROUPS, G_DIM)
    vs = _layernorm(vs, sgu_norm_w.reshape(G_GROUPS, G_DIM), sgu_norm_b.reshape(G_GROUPS, G_DIM))
    vs = vs.reshape(B, S // SGU_CHUNK, SGU_CHUNK, G_GROUPS, G_DIM)
    tril = jnp.tril(jnp.ones((SGU_CHUNK, SGU_CHUNK), dtype=w_spatial.dtype))
    ws = w_spatial * tril
    sp = jnp.einsum('gts,bcsgd->bctgd', ws, vs) + b_spatial.T[None, None, :, :, None]
    y_s = u * sp.reshape(B, S, D_SGU)

    y = jnp.concatenate([y_m, y_s], axis=-1)
    return jnp.einsum('bsc,cd->bsd', y, w_out)


def _swiglu(x, w_gate, w_up, w_down):
    hdn = jax.nn.silu(jnp.einsum('bsd,df->bsf', x, w_gate)) * jnp.einsum('bsd,df->bsf', x, w_up)
    return jnp.einsum('bsf,fd->bsd', hdn, w_down)


def setup_inputs(seed: int = 0) -> dict:
    key = jax.random.key(seed)
    ks = jax.random.split(key, 20)
    f32 = jnp.float32

    def nrm(k, shape, scale):
        return jax.random.normal(k, shape, f32) * scale

    x = jax.random.normal(ks[0], (BATCH, SEQ, D_MODEL), f32)
    w_in = nrm(ks[1], (DEPTH, D_MODEL, N_IN_COLS), D_MODEL ** -0.5)
    f_bias = jnp.broadcast_to(jnp.linspace(3.0, 6.0, M_HEADS, dtype=f32), (DEPTH, M_HEADS))
    i_bias = nrm(ks[2], (DEPTH, M_HEADS), 0.1)
    b_gates = jnp.concatenate([i_bias, f_bias + nrm(ks[3], (DEPTH, M_HEADS), 0.1)], axis=-1)
    conv_qk = nrm(ks[4], (DEPTH, CONV_K, 2 * D_MLSTM), CONV_K ** -0.5)
    mlstm_norm_w = 1.0 + nrm(ks[5], (DEPTH, D_MLSTM), 0.02)
    sgu_norm_w = 1.0 + nrm(ks[6], (DEPTH, D_SGU), 0.02)
    sgu_norm_b = nrm(ks[7], (DEPTH, D_SGU), 0.02)
    w_spatial = nrm(ks[8], (DEPTH, G_GROUPS, SGU_CHUNK, SGU_CHUNK), 0.5 * SGU_CHUNK ** -0.5)
    b_spatial = 1.0 + nrm(ks[9], (DEPTH, G_GROUPS, SGU_CHUNK), 0.1)
    w_out = nrm(ks[10], (DEPTH, D_MIX, D_MODEL), BETA * D_MIX ** -0.5)
    ln1_w = 1.0 + nrm(ks[11], (DEPTH, D_MODEL), 0.02)
    ln1_b = nrm(ks[12], (DEPTH, D_MODEL), 0.02)
    w_gate = nrm(ks[13], (DEPTH, D_MODEL, D_FF), D_MODEL ** -0.5)
    w_up = nrm(ks[14], (DEPTH, D_MODEL, D_FF), D_MODEL ** -0.5)
    w_down = nrm(ks[15], (DEPTH, D_FF, D_MODEL), BETA * D_FF ** -0.5)
    ln2_w = 1.0 + nrm(ks[16], (DEPTH, D_MODEL), 0.02)
    ln2_b = nrm(ks[17], (DEPTH, D_MODEL), 0.02)
    return {"x": x, "w_in": w_in, "b_gates": b_gates, "conv_qk": conv_qk,
            "mlstm_norm_w": mlstm_norm_w, "sgu_norm_w": sgu_norm_w, "sgu_norm_b": sgu_norm_b,
            "w_spatial": w_spatial, "b_spatial": b_spatial, "w_out": w_out,
            "ln1_w": ln1_w, "ln1_b": ln1_b, "w_gate": w_gate, "w_up": w_up,
            "w_down": w_down, "ln2_w": ln2_w, "ln2_b": ln2_b}


def reference(x, w_in, b_gates, conv_qk, mlstm_norm_w, sgu_norm_w, sgu_norm_b,
              w_spatial, b_spatial, w_out, ln1_w, ln1_b, w_gate, w_up, w_down,
              ln2_w, ln2_b):
    h = x
    for l in range(DEPTH):
        mix = _hybrid_mixer(h, w_in[l], b_gates[l], conv_qk[l], mlstm_norm_w[l],
                            sgu_norm_w[l], sgu_norm_b[l], w_spatial[l], b_spatial[l], w_out[l])
        h = _layernorm(ALPHA * h + mix, ln1_w[l], ln1_b[l])
        ffn = _swiglu(h, w_gate[l], w_up[l], w_down[l])
        h = _layernorm(ALPHA * h + ffn, ln2_w[l], ln2_b[l])
    return h
```

```cpp
#include <hip/hip_runtime.h>
#include <hip/hip_cooperative_groups.h>
#include <cstdio>
#include <cstddef>
namespace cg = cooperative_groups;
namespace pg8 {
#define PG8_LAS __attribute__((address_space(3)))
typedef unsigned short bf16_t;
typedef short bf16x8 __attribute__((ext_vector_type(8)));
typedef float f32x4 __attribute__((ext_vector_type(4)));
typedef unsigned u32x4 __attribute__((ext_vector_type(4)));
constexpr int BM = 256, BK = 64, HALF = 128, HTB = HALF * BK * 2  , STAGE_BYTES = 8 * HTB, NXCD = 8, WGM = 8;

__host__ __device__ __forceinline__ int lds_byte(int r, int c) { const int st = (r >> 4) * 2 + (c >> 5), rr = r & 15, cc = c & 31, ob = rr * 64 + cc * 2; return st * 1024 + (ob ^ (((ob >> 9) & 1) << 5)); }
__host__ __device__ __forceinline__ void stage_rc(int b, int& R, int& C) { const int st = b / 1024, sb = b % 1024, swz = sb ^ (((sb >> 9) & 1) << 5); R = (st >> 1) * 16 + swz / 64; C = (st & 1) * 32 + (swz % 64) / 2; }
__host__ __device__ __forceinline__ int perm32(int rho) { const int n = rho >> 4, i = rho & 15; return 8 * (i >> 2) + 4 * n + (i & 3); }

struct Unit { int pm, pn; };
struct Gemm { const bf16_t* A; const bf16_t* Bt; int M, N, K; };

struct StaticOrder {
    int nM, nN, nwg, G, c;
    __host__ __device__ void init(int M, int N, int G_, int c_) { nM = M / BM; nN = N / BM; nwg = nM * nN; G = G_; c = c_; }
    __host__ __device__ bool next(int i, Unit& u) const {
        const long L = (long)i * G + c; if (L >= nwg) return false;
        int wgid = (int)L; { const int q = nwg / NXCD, r = nwg % NXCD, xcd = wgid % NXCD, off = wgid / NXCD; wgid = (xcd < r ? xcd * (q + 1) : r * (q + 1) + (xcd - r) * q) + off; }
        const int nig = WGM * nN, gid = wgid / nig, fm = gid * WGM, gsz = (nM - fm) < WGM ? (nM - fm) : WGM;
        u.pm = fm + ((wgid % nig) % gsz); u.pn = (wgid % nig) / gsz; return true;
    }
    __device__ __forceinline__ void a_ready(const Unit&) const {}
    __device__ __forceinline__ void done(const Unit&) const {}
};
struct CountedOrder : StaticOrder {
    const unsigned* ready; unsigned need; unsigned* tmo;
    __device__ __forceinline__ void a_ready(const Unit& u) const {
        if (threadIdx.x < 64) {
            const unsigned long long t0 = __builtin_amdgcn_s_memrealtime(); unsigned polls = 0;
            while ((unsigned)__builtin_amdgcn_readfirstlane(__hip_atomic_load(ready + 64 * u.pm, __ATOMIC_RELAXED, __HIP_MEMORY_SCOPE_AGENT)) < need) {
                if ((++polls & 255u) == 0u && __builtin_amdgcn_readfirstlane(__hip_atomic_load(tmo, __ATOMIC_RELAXED, __HIP_MEMORY_SCOPE_AGENT)) != 0u) break;
                if (__builtin_amdgcn_s_memrealtime() - t0 > 2000000ull) {
                    if (threadIdx.x == 0) { unsigned expect = 0u; __hip_atomic_compare_exchange_strong(tmo + 1, &expect, 0x600u | (unsigned)(u.pm & 0xff), __ATOMIC_RELAXED, __ATOMIC_RELAXED, __HIP_MEMORY_SCOPE_AGENT); __hip_atomic_store(tmo, 1u, __ATOMIC_RELAXED, __HIP_MEMORY_SCOPE_AGENT); }
                    break; }
                __builtin_amdgcn_s_sleep(2); }
            __builtin_amdgcn_fence(__ATOMIC_ACQUIRE, "agent");
            asm volatile("s_waitcnt vmcnt(0)" ::: "memory");
        }
#if !defined(BROKEN_HOOK_NO_BARRIER)
        asm volatile("" ::: "memory"); __builtin_amdgcn_s_barrier(); asm volatile("" ::: "memory");
#endif
    }
};

__device__ __forceinline__ unsigned cvt_pk_bf16(float lo, float hi) { unsigned r; asm volatile("v_cvt_pk_bf16_f32 %0, %1, %2" : "=v"(r) : "v"(lo), "v"(hi)); return r; }
typedef float f32x2 __attribute__((ext_vector_type(2)));
__device__ __forceinline__ f32x2 gelu_pk(f32x2 v) {
    const f32x2 av = __builtin_elementwise_abs(v), d = av * 0.2316418882f + 1.0f;
    f32x2 t; t.x = __builtin_amdgcn_rcpf(d.x); t.y = __builtin_amdgcn_rcpf(d.y);
    f32x2 q = t * 0.5307027145f + (-0.7265760135f); q = q * t + 0.7107068705f; q = q * t + (-0.142248368f); q = q * t + 0.127414796f; q = q * t;
    const f32x2 s = (v * v) * (-0.72134752044f);
    f32x2 e; e.x = __builtin_amdgcn_exp2f(s.x); e.y = __builtin_amdgcn_exp2f(s.y);
    const f32x2 m = v * (q * e), r = v - m;
    f32x2 o; o.x = v.x < 0.f ? m.x : r.x; o.y = v.y < 0.f ? m.y : r.y; return o;
}

template <class Epi, class Sched, bool STAMP = false>
__device__ __forceinline__ void gemm_phase(PG8_LAS unsigned char* lds, const Gemm g, const Sched& S, const Epi& E, unsigned long long* stamps) {
    const int tid = threadIdx.x, wid = __builtin_amdgcn_readfirstlane(tid >> 6), lane = tid & 63, wr = wid >> 2, wc = wid & 3, fr = lane & 15, fq = lane >> 4;
    const int K = g.K, nt = K / BK;
    int ts_lo = 0, ts_hi = 0, nts = 0; const unsigned long long rt_entry = STAMP ? (unsigned long long)wall_clock64() : 0ull;
#define PG8_STAMP() do { if (STAMP && wid == 0 && nts < 64) { const unsigned long long _c = (unsigned long long)clock64(); \
        ts_lo = (lane == nts) ? (int)(unsigned)_c : ts_lo; ts_hi = (lane == nts) ? (int)(unsigned)(_c >> 32) : ts_hi; ++nts; } } while (0)
    PG8_STAMP();
    unsigned voffA[2], voffB[2];
#pragma unroll
    for (int i = 0; i < 2; ++i) { int R, C; stage_rc(tid * 16 + i * 8192, R, C); const int Rb = Epi::PERM ? ((R & ~31) + perm32(R & 31)) : R;
        voffA[i] = (unsigned)(R * K + C) * 2u; voffB[i] = (unsigned)(Rb * K + C) * 2u; }
    const size_t kstep = (size_t)(BK * 2);
    const size_t hstep = (size_t)HALF * K * 2;
    const size_t tstep = 2 * hstep;
    const unsigned ldsw = (unsigned)wid * 1024u;
    const int aoff = lds_byte(wr * 64 + fr, fq * 8), boff = lds_byte(wc * 32 + fr, fq * 8);
#define PG8_SA(b, h) (((b) * 2 + (h)) * HTB)
#define PG8_SB(b, h) ((4 + (b) * 2 + (h)) * HTB)
#define PG8_STAGE(bufoff, gbase, voff) do { _Pragma("unroll") for (int _i = 0; _i < 2; ++_i) \
        __builtin_amdgcn_global_load_lds((const unsigned*)((const char*)(gbase) + (voff)[_i]), (PG8_LAS unsigned*)(lds + (bufoff) + ldsw + _i * 8192), 16, 0, 0); } while (0)
#define PG8_LDA(dst, b, h) do { _Pragma("unroll") for (int m = 0; m < 4; ++m) _Pragma("unroll") for (int k = 0; k < 2; ++k) dst[m][k] = *(const PG8_LAS bf16x8*)(lds + PG8_SA(b, h) + aoff + m * 2048 + k * 1024); } while (0)
#define PG8_LDB(dst, b, h) do { _Pragma("unroll") for (int n = 0; n < 2; ++n) _Pragma("unroll") for (int k = 0; k < 2; ++k) dst[n][k] = *(const PG8_LAS bf16x8*)(lds + PG8_SB(b, h) + boff + n * 2048 + k * 1024); } while (0)
#define PG8_MMA(ai, bj, At, Bt) do { __builtin_amdgcn_s_setprio(1); _Pragma("unroll") for (int m = 0; m < 4; ++m) _Pragma("unroll") for (int n = 0; n < 2; ++n) _Pragma("unroll") for (int k = 0; k < 2; ++k) \
        acc[ai][bj][m][n] = __builtin_amdgcn_mfma_f32_16x16x32_bf16(Bt[n][k], At[m][k], acc[ai][bj][m][n], 0, 0, 0); __builtin_amdgcn_s_setprio(0); } while (0)
#define PG8_WAIT_V(n) asm volatile("s_waitcnt vmcnt(" #n ")" ::: "memory")
#define PG8_WAIT_L(n) asm volatile("s_waitcnt lgkmcnt(" #n ")" ::: "memory")
#define PG8_BAR __builtin_amdgcn_s_barrier()
#define PG8_SCHED __builtin_amdgcn_sched_barrier(0)
    Unit cur, nxt; int ui = 0;
    if (!S.next(0, cur)) return;
    f32x4 acc[2][2][4][2];
#pragma unroll
    for (int a = 0; a < 2; ++a)
#pragma unroll
        for (int b = 0; b < 2; ++b)
#pragma unroll
            for (int m = 0; m < 4; ++m)
#pragma unroll
                for (int n = 0; n < 2; ++n) acc[a][b][m][n] = (f32x4){0.f, 0.f, 0.f, 0.f};
    bf16x8 At[4][2], B0[2][2], B1[2][2];
    const char* cA = (const char*)g.A + (size_t)cur.pm * tstep; const char* cB = (const char*)g.Bt + (size_t)cur.pn * tstep;
    S.a_ready(cur);
    PG8_STAGE(PG8_SB(0, 0), cB, voffB); PG8_STAGE(PG8_SA(0, 0), cA, voffA); PG8_STAGE(PG8_SB(0, 1), cB + hstep, voffB); PG8_STAGE(PG8_SA(0, 1), cA + hstep, voffA);
    if (wr == 1) PG8_BAR;
    PG8_WAIT_V(4); PG8_BAR;
    PG8_STAGE(PG8_SB(1, 0), cB + kstep, voffB); PG8_STAGE(PG8_SA(1, 0), cA + kstep, voffA); PG8_STAGE(PG8_SB(1, 1), cB + hstep + kstep, voffB);
    PG8_WAIT_V(6); PG8_BAR;
    PG8_STAMP();
    for (;;) {
        const bool has_next = S.next(ui + 1, nxt);
        const char* nA = has_next ? (const char*)g.A + (size_t)nxt.pm * tstep : cA; const char* nB = has_next ? (const char*)g.Bt + (size_t)nxt.pn * tstep : cB;
        for (int t = 0; t < nt; t += 2) {
            const bool last = (t == nt - 2);
            const char* a1 = cA + (size_t)(t + 1) * kstep;
            const char* a2 = last ? nA : cA + (size_t)(t + 2) * kstep; const char* b2 = last ? nB : cB + (size_t)(t + 2) * kstep;
            const char* a3 = a2 + kstep; const char* b3 = b2 + kstep;
            if (last && has_next) S.a_ready(nxt);
            PG8_LDB(B0, 0, 0); PG8_SCHED; PG8_LDA(At, 0, 0); PG8_STAGE(PG8_SA(1, 1), a1 + hstep, voffA);
            PG8_WAIT_L(8); PG8_BAR; PG8_WAIT_L(0); PG8_MMA(0, 0, At, B0); PG8_BAR; PG8_SCHED;
            PG8_LDB(B1, 0, 1); PG8_STAGE(PG8_SB(0, 0), b2, voffB);
            PG8_BAR; PG8_WAIT_L(0); PG8_MMA(0, 1, At, B1); PG8_BAR;
            PG8_LDA(At, 0, 1); PG8_STAGE(PG8_SA(0, 0), a2, voffA);
            PG8_BAR; PG8_WAIT_L(0); PG8_MMA(1, 0, At, B0); PG8_BAR; PG8_SCHED;
            PG8_STAGE(PG8_SB(0, 1), b2 + hstep, voffB);
            PG8_WAIT_V(6); PG8_BAR; PG8_MMA(1, 1, At, B1); PG8_BAR;
            PG8_LDB(B0, 1, 0); PG8_SCHED; PG8_LDA(At, 1, 0); PG8_STAGE(PG8_SA(0, 1), a2 + hstep, voffA);
            PG8_WAIT_L(8); PG8_BAR; PG8_WAIT_L(0); PG8_MMA(0, 0, At, B0); PG8_BAR; PG8_SCHED;
            PG8_LDB(B1, 1, 1); PG8_STAGE(PG8_SB(1, 0), b3, voffB);
            PG8_BAR; PG8_WAIT_L(0); PG8_MMA(0, 1, At, B1); PG8_BAR;
            PG8_LDA(At, 1, 1); PG8_STAGE(PG8_SA(1, 0), a3, voffA);
            PG8_BAR; PG8_WAIT_L(0); PG8_MMA(1, 0, At, B0); PG8_BAR; PG8_SCHED;
            PG8_STAGE(PG8_SB(1, 1), b3 + hstep, voffB);
            PG8_WAIT_V(6); PG8_BAR; PG8_MMA(1, 1, At, B1); PG8_BAR;
        }
        PG8_STAMP();
        if constexpr (!Epi::AFTER_DRAIN) { E(acc, cur, wr, wc, fr, fq); S.done(cur); }
        PG8_STAMP();
        if (!has_next) break;
#pragma unroll
        for (int a = 0; a < 2; ++a)
#pragma unroll
            for (int b = 0; b < 2; ++b)
#pragma unroll
                for (int m = 0; m < 4; ++m)
#pragma unroll
                    for (int n = 0; n < 2; ++n) acc[a][b][m][n] = (f32x4){0.f, 0.f, 0.f, 0.f};
        cur = nxt; cA = nA; cB = nB; ++ui;
    }
    PG8_WAIT_V(0);
    if (wr == 0) PG8_BAR;
    PG8_BAR;
    if constexpr (Epi::AFTER_DRAIN) { E.fused(acc, cur, wr, wc, fr, fq, lds, wid, lane); S.done(cur); }
    PG8_STAMP();
    if (STAMP && wid == 0) { stamps[lane] = lane < nts ? (((unsigned long long)(unsigned)ts_hi << 32) | (unsigned)ts_lo) : 0ull;
        if (lane == 62) stamps[62] = rt_entry; if (lane == 63) stamps[63] = (unsigned long long)wall_clock64(); }
#undef PG8_STAMP
#undef PG8_SA
#undef PG8_SB
#undef PG8_STAGE
#undef PG8_LDA
#undef PG8_LDB
#undef PG8_MMA
#undef PG8_WAIT_V
#undef PG8_WAIT_L
#undef PG8_BAR
#undef PG8_SCHED
}
}

using pg8::bf16_t; using pg8::bf16x8; using pg8::f32x4; using pg8::u32x4; using pg8::f32x2; using pg8::cvt_pk_bf16;
#define LAS __attribute__((address_space(3)))
typedef unsigned u32x2 __attribute__((ext_vector_type(2)));

constexpr int T_TOK = 16384, DM = 1024, SEQ = 8192, NP = 3072, DFF = 2816, NIN = 3080;
constexpr float ALPHA = 1.189207115002721f;
constexpr float LN_EPS = 1e-5f;
constexpr size_t MiB = (size_t)1 << 20;
constexpr size_t WS_WINT = 0, WS_WOUTT = 6 * MiB, WS_WGUT = 8 * MiB, WS_WDOWNT = 19 * MiB, WS_GATES = 24 * MiB + 512 * 1024, WS_SMALL = 25 * MiB,
                 WS_P = 26 * MiB, WS_XB = 122 * MiB, WS_DC = 122 * MiB, WS_CPREV = 154 * MiB, WS_Y = 170 * MiB, WS_R1 = 26 * MiB, WS_H1B = 90 * MiB, WS_HDN = 122 * MiB;
constexpr size_t SM_DN = 0, SM_NPREV = 256 * 1024, SM_MLOC = 512 * 1024, SM_GTOT = 512 * 1024 + 2048, SM_MPREV = 512 * 1024 + 4096;
constexpr int LDS_BYTES = 132 * 1024;

struct Params { const float* in[17]; float* out; unsigned char* ws; };

__device__ __forceinline__ float bflo(unsigned w) { return __uint_as_float(w << 16); }
__device__ __forceinline__ float bfhi(unsigned w) { return __uint_as_float(w & 0xffff0000u); }
__device__ __forceinline__ unsigned short f2bf(float f) { unsigned u = __float_as_uint(f); u += 0x7fffu + ((u >> 16) & 1u); return (unsigned short)(u >> 16); }
__device__ __forceinline__ void unpack8(const u32x4 r, float (&x)[8]) {
    x[0] = bflo(r.x); x[1] = bfhi(r.x); x[2] = bflo(r.y); x[3] = bfhi(r.y); x[4] = bflo(r.z); x[5] = bfhi(r.z); x[6] = bflo(r.w); x[7] = bfhi(r.w); }
__device__ __forceinline__ float logsigmoid(float f) { return fminf(f, 0.f) - log1pf(expf(-fabsf(f))); }
__device__ __forceinline__ float siluf(float y) { return y / (1.f + __expf(-y)); }
__device__ __forceinline__ int swz(int r, int c) { return r * 128 + ((((c >> 3) ^ r ^ (r >> 3)) & 15) << 3) + (c & 7); }

__device__ __forceinline__ void wave_mm(const LAS bf16_t* A, const LAS bf16_t* B, f32x4 (&acc)[8], int row0, int fr, int fq, int nks, int ntiles) {
    const int ra = row0 + fr, ka = ra ^ (ra >> 3);
#pragma unroll 1
    for (int kk = 0; kk < nks; ++kk) {
        const int kb = kk * 4 + fq;
        const bf16x8 a = *(const LAS bf16x8*)(A + ra * 128 + (((kb ^ ka) & 15) << 3));
#pragma unroll
        for (int n = 0; n < 8; ++n) {
            if (n < ntiles) {
                const int rb = n * 16 + fr;
                const bf16x8 b = *(const LAS bf16x8*)(B + rb * 128 + (((kb ^ rb ^ (rb >> 3)) & 15) << 3));
                acc[n] = __builtin_amdgcn_mfma_f32_16x16x32_bf16(b, a, acc[n], 0, 0, 0);
            }
        }
    }
}

struct EpiP {
    static constexpr bool PERM = true, AFTER_DRAIN = false;
    bf16_t* O;
    __device__ __forceinline__ void operator()(const f32x4 (&acc)[2][2][4][2], const pg8::Unit& u, int wr, int wc, int fr, int fq) const {
        const int row0 = u.pm * 256 + wr * 64 + fr, col0 = u.pn * 256 + wc * 32 + 8 * fq;
        const bool act = u.pn >= 8;
#pragma unroll
        for (int ai = 0; ai < 2; ++ai)
#pragma unroll
            for (int m = 0; m < 4; ++m) { bf16_t* rowp = O + (size_t)(row0 + ai * 128 + m * 16) * NP + col0;
#pragma unroll
                for (int bj = 0; bj < 2; ++bj) { f32x4 v0 = acc[ai][bj][m][0], v1 = acc[ai][bj][m][1];
                    if (act) { f32x2 a = pg8::gelu_pk((f32x2){v0[0], v0[1]}), b = pg8::gelu_pk((f32x2){v0[2], v0[3]}), c = pg8::gelu_pk((f32x2){v1[0], v1[1]}), d = pg8::gelu_pk((f32x2){v1[2], v1[3]});
                        v0 = (f32x4){a.x, a.y, b.x, b.y}; v1 = (f32x4){c.x, c.y, d.x, d.y}; }
                    u32x4 w; w.x = cvt_pk_bf16(v0[0], v0[1]); w.y = cvt_pk_bf16(v0[2], v0[3]); w.z = cvt_pk_bf16(v1[0], v1[1]); w.w = cvt_pk_bf16(v1[2], v1[3]);
                    *(u32x4*)(rowp + bj * 128) = w; } }
    }
};
struct EpiRes {
    static constexpr bool PERM = false, AFTER_DRAIN = false;
    float* C; const float* R;
    __device__ __forceinline__ void operator()(const f32x4 (&acc)[2][2][4][2], const pg8::Unit& u, int wr, int wc, int fr, int fq) const {
        const int row0 = u.pm * 256 + wr * 64 + fr, col0 = u.pn * 256 + wc * 32 + 4 * fq;
#pragma unroll
        for (int ai = 0; ai < 2; ++ai)
#pragma unroll
            for (int m = 0; m < 4; ++m) { const size_t off = (size_t)(row0 + ai * 128 + m * 16) * DM + col0;
#pragma unroll
                for (int bj = 0; bj < 2; ++bj)
#pragma unroll
                    for (int n = 0; n < 2; ++n) { const f32x4 r = *(const f32x4*)(R + off + bj * 128 + n * 16); *(f32x4*)(C + off + bj * 128 + n * 16) = acc[ai][bj][m][n] + ALPHA * r; } }
    }
};
struct EpiSwiglu {
    static constexpr bool PERM = true, AFTER_DRAIN = false;
    bf16_t* O;
    __device__ __forceinline__ void operator()(const f32x4 (&acc)[2][2][4][2], const pg8::Unit& u, int wr, int wc, int fr, int fq) const {
        const int row0 = u.pm * 256 + wr * 64 + fr, col0 = u.pn * 128 + wc * 32 + 8 * fq;
#pragma unroll
        for (int ai = 0; ai < 2; ++ai)
#pragma unroll
            for (int m = 0; m < 4; ++m) { bf16_t* rowp = O + (size_t)(row0 + ai * 128 + m * 16) * DFF + col0;
                float h[8];
#pragma unroll
                for (int n = 0; n < 2; ++n)
#pragma unroll
                    for (int j = 0; j < 4; ++j) h[n * 4 + j] = siluf(acc[ai][0][m][n][j]) * acc[ai][1][m][n][j];
                u32x4 w; w.x = cvt_pk_bf16(h[0], h[1]); w.y = cvt_pk_bf16(h[2], h[3]); w.z = cvt_pk_bf16(h[4], h[5]); w.w = cvt_pk_bf16(h[6], h[7]);
                *(u32x4*)rowp = w; }
    }
};

__device__ __forceinline__ void phase_prep(const Params& P, LAS unsigned char* lds) {
    const int tid = threadIdx.x, lane = tid & 63, wid = __builtin_amdgcn_readfirstlane(tid >> 6);
    unsigned char* ws = P.ws;
    LAS float* tile = (LAS float*)lds;
    for (int t = blockIdx.x; t < 3136; t += gridDim.x) {
        const float* src; bf16_t* dst; int lsrc, ldd, k0, scol, drow;
        if (t < 768) { const int kt = t / 48, nt = t % 48, n0 = nt * 64; src = P.in[1]; lsrc = NIN; scol = n0 < 2048 ? n0 : n0 + 8; dst = (bf16_t*)(ws + WS_WINT); ldd = 1024; drow = n0; k0 = kt * 64; }
        else if (t < 1024) { const int t2 = t - 768, kt = t2 >> 4, nt = t2 & 15; src = P.in[9]; lsrc = 1024; scol = nt * 64; dst = (bf16_t*)(ws + WS_WOUTT); ldd = 1024; drow = nt * 64; k0 = kt * 64; }
        else if (t < 2432) { const int t2 = t - 1024, kt = t2 / 88, nt = t2 % 88, n0 = nt * 64, pn = n0 >> 8, bj = (n0 >> 7) & 1; src = bj ? P.in[13] : P.in[12]; lsrc = DFF; scol = pn * 128 + (n0 & 127);
            dst = (bf16_t*)(ws + WS_WGUT); ldd = 1024; drow = n0; k0 = kt * 64; }
        else { const int t2 = t - 2432, kt = t2 >> 4, nt = t2 & 15; src = P.in[14]; lsrc = 1024; scol = nt * 64; dst = (bf16_t*)(ws + WS_WDOWNT); ldd = DFF; drow = nt * 64; k0 = kt * 64; }
#pragma unroll
        for (int i = 0; i < 8; ++i) { const int r = i * 8 + wid; tile[r * 65 + lane] = src[(size_t)(k0 + r) * lsrc + scol + lane]; }
        __syncthreads();
        { const int n = tid >> 3, ks = (tid & 7) * 8; float v[8];
#pragma unroll
          for (int j = 0; j < 8; ++j) v[j] = tile[(ks + j) * 65 + n];
          u32x4 w; w.x = cvt_pk_bf16(v[0], v[1]); w.y = cvt_pk_bf16(v[2], v[3]); w.z = cvt_pk_bf16(v[4], v[5]); w.w = cvt_pk_bf16(v[6], v[7]);
          *(u32x4*)(dst + (size_t)(drow + n) * ldd + k0 + ks) = w; }
        __syncthreads();
    }
    LAS float* wg = (LAS float*)(lds + 32768);
    for (int i = tid; i < 8192; i += 512) wg[i] = P.in[1][(size_t)(i >> 3) * NIN + 2048 + (i & 7)];
    __syncthreads();
    bf16_t* xb = (bf16_t*)(ws + WS_XB); float* gates = (float*)(ws + WS_GATES);
    const float bg = P.in[2][lane & 7];
    for (int row = blockIdx.x * 8 + wid; row < T_TOK; row += gridDim.x * 8) {
        const f32x4* xr = (const f32x4*)(P.in[0] + (size_t)row * DM);
        float a[8];
#pragma unroll
        for (int j = 0; j < 8; ++j) a[j] = 0.f;
#pragma unroll
        for (int i = 0; i < 4; ++i) { const f32x4 v = xr[i * 64 + lane]; const int k = (i * 64 + lane) * 4;
            u32x2 w; w.x = cvt_pk_bf16(v[0], v[1]); w.y = cvt_pk_bf16(v[2], v[3]); *(u32x2*)(xb + (size_t)row * DM + k) = w;
#pragma unroll
            for (int e = 0; e < 4; ++e) { const f32x4 w0 = *(const LAS f32x4*)(wg + (k + e) * 8), w1 = *(const LAS f32x4*)(wg + (k + e) * 8 + 4);
                a[0] += v[e] * w0[0]; a[1] += v[e] * w0[1]; a[2] += v[e] * w0[2]; a[3] += v[e] * w0[3]; a[4] += v[e] * w1[0]; a[5] += v[e] * w1[1]; a[6] += v[e] * w1[2]; a[7] += v[e] * w1[3]; } }
#pragma unroll
        for (int j = 0; j < 8; ++j) {
#pragma unroll
            for (int o = 32; o >= 1; o >>= 1) a[j] += __shfl_xor(a[j], o); }
        float r = a[0]; r = (lane == 1) ? a[1] : r; r = (lane == 2) ? a[2] : r; r = (lane == 3) ? a[3] : r; r = (lane == 4) ? a[4] : r; r = (lane == 5) ? a[5] : r; r = (lane == 6) ? a[6] : r; r = (lane == 7) ? a[7] : r;
        if (lane < 8) gates[(size_t)row * 8 + lane] = r + bg;
    }
    __syncthreads();
}

__device__ __forceinline__ void conv_silu8(const bf16_t* pk, const float* cw, int pos, float (&y)[8]) {
#pragma unroll
    for (int i = 0; i < 8; ++i) y[i] = 0.f;
#pragma unroll
    for (int j = 0; j < 4; ++j) {
        if (pos + j - 3 >= 0) {
            const u32x4 raw = *(const u32x4*)(pk + (ptrdiff_t)(j - 3) * NP); float x[8]; unpack8(raw, x);
            const f32x4 w0 = *(const f32x4*)(cw + j * 1024), w1 = *(const f32x4*)(cw + j * 1024 + 4);
            y[0] += w0[0] * x[0]; y[1] += w0[1] * x[1]; y[2] += w0[2] * x[2]; y[3] += w0[3] * x[3]; y[4] += w1[0] * x[4]; y[5] += w1[1] * x[5]; y[6] += w1[2] * x[6]; y[7] += w1[3] * x[7];
        }
    }
#pragma unroll
    for (int i = 0; i < 8; ++i) y[i] = siluf(y[i]);
}

__device__ __forceinline__ void mlstm_local(const Params& P, LAS unsigned char* lds, int task) {
    const int tid = threadIdx.x, lane = tid & 63, wid = __builtin_amdgcn_readfirstlane(tid >> 6), fr = lane & 15, fq = lane >> 4;
    const int bh = task >> 6, c = task & 63, b = bh >> 2, h = bh & 3, tok0 = b * SEQ + c * 128;
    unsigned char* ws = P.ws;
    LAS bf16_t* Vt = (LAS bf16_t*)lds; LAS bf16_t* Kt = (LAS bf16_t*)(lds + 32768); LAS float* wsl = (LAS float*)(lds + 65536);
    const float* gates = (const float*)(ws + WS_GATES); const bf16_t* p = (const bf16_t*)(ws + WS_P);
    if (wid == 0) {
        const int l0 = 2 * lane;
        const float i0 = gates[(size_t)(tok0 + l0) * 8 + h], i1 = gates[(size_t)(tok0 + l0 + 1) * 8 + h];
        const float lf0 = logsigmoid(gates[(size_t)(tok0 + l0) * 8 + 4 + h]), lf1 = logsigmoid(gates[(size_t)(tok0 + l0 + 1) * 8 + 4 + h]);
        const float s1 = lf0 + lf1; float tot = s1;
#pragma unroll
        for (int o = 1; o < 64; o <<= 1) { const float t = __shfl_up(tot, o); if (lane >= o) tot += t; }
        const float ex = tot - s1, b0 = ex + lf0, b1 = ex + s1, g = __shfl(tot, 63);
        const float w0 = g - b0 + i0, w1 = g - b1 + i1; float mx = fmaxf(w0, w1);
#pragma unroll
        for (int o = 32; o >= 1; o >>= 1) mx = fmaxf(mx, __shfl_xor(mx, o));
        wsl[l0] = __expf(w0 - mx); wsl[l0 + 1] = __expf(w1 - mx);
        if (lane == 0) { ((float*)(ws + WS_SMALL + SM_GTOT))[task] = g; ((float*)(ws + WS_SMALL + SM_MLOC))[task] = mx; }
    }
    __syncthreads();
#pragma unroll 1
    for (int it = 0; it < 4; ++it) {
        const int l = it * 32 + wid * 4 + (lane & 3), ch = lane >> 2, tok = tok0 + l, pos = c * 128 + l;
        float y[8]; conv_silu8(p + (size_t)tok * NP + 512 + h * 128 + ch * 8, P.in[3] + 512 + h * 128 + ch * 8, pos, y);
        const float sc = wsl[l] * 0.08838834764831845f;
#pragma unroll
        for (int i = 0; i < 8; ++i) Kt[swz(ch * 8 + i, l)] = f2bf(y[i] * sc);
        const u32x4 raw = *(const u32x4*)(p + (size_t)tok * NP + 1024 + h * 128 + ch * 8);
        Vt[swz(ch * 8 + 0, l)] = (bf16_t)(raw.x & 0xffffu); Vt[swz(ch * 8 + 1, l)] = (bf16_t)(raw.x >> 16);
        Vt[swz(ch * 8 + 2, l)] = (bf16_t)(raw.y & 0xffffu); Vt[swz(ch * 8 + 3, l)] = (bf16_t)(raw.y >> 16);
        Vt[swz(ch * 8 + 4, l)] = (bf16_t)(raw.z & 0xffffu); Vt[swz(ch * 8 + 5, l)] = (bf16_t)(raw.z >> 16);
        Vt[swz(ch * 8 + 6, l)] = (bf16_t)(raw.w & 0xffffu); Vt[swz(ch * 8 + 7, l)] = (bf16_t)(raw.w >> 16);
    }
    __syncthreads();
    f32x4 acc[8];
#pragma unroll
    for (int n = 0; n < 8; ++n) acc[n] = (f32x4){0.f, 0.f, 0.f, 0.f};
    wave_mm(Vt, Kt, acc, wid * 16, fr, fq, 4, 8);
    float* dC = (float*)(ws + WS_DC) + (size_t)task * 16384 + (wid * 16 + fr) * 128 + fq * 4;
#pragma unroll
    for (int n = 0; n < 8; ++n) *(f32x4*)(dC + n * 16) = acc[n];
    if (tid < 128) { float s = 0.f;
#pragma unroll
        for (int blk = 0; blk < 16; ++blk) { const u32x4 r = *(const LAS u32x4*)(Kt + tid * 128 + blk * 8); float x[8]; unpack8(r, x); s += ((x[0] + x[1]) + (x[2] + x[3])) + ((x[4] + x[5]) + (x[6] + x[7])); }
        ((float*)(ws + WS_SMALL + SM_DN))[task * 128 + tid] = s; }
    __syncthreads();
}

__device__ __forceinline__ void sgu_task(const Params& P, LAS unsigned char* lds, int task) {
    const int tid = threadIdx.x, lane = tid & 63, wid = __builtin_amdgcn_readfirstlane(tid >> 6), fr = lane & 15, fq = lane >> 4;
    const int b = task >> 8, c = (task >> 2) & 63, g = task & 3, tok0 = b * SEQ + c * 128;
    unsigned char* ws = P.ws;
    LAS bf16_t* Wl = (LAS bf16_t*)lds; LAS bf16_t* Vst = (LAS bf16_t*)(lds + 32768);
    const bf16_t* p = (const bf16_t*)(ws + WS_P);
#pragma unroll 1
    for (int it = 0; it < 4; ++it) {
        const int i = it * 512 + tid, t = i >> 4, sb = i & 15;
        const float* src = P.in[7] + (size_t)g * 16384 + t * 128 + sb * 8;
        const f32x4 a = *(const f32x4*)src, bq = *(const f32x4*)(src + 4); const int s0 = sb * 8;
        float v[8] = {a[0], a[1], a[2], a[3], bq[0], bq[1], bq[2], bq[3]};
#pragma unroll
        for (int e = 0; e < 8; ++e) v[e] = (s0 + e <= t) ? v[e] : 0.f;
        u32x4 w; w.x = cvt_pk_bf16(v[0], v[1]); w.y = cvt_pk_bf16(v[2], v[3]); w.z = cvt_pk_bf16(v[4], v[5]); w.w = cvt_pk_bf16(v[6], v[7]);
        *(LAS u32x4*)(Wl + swz(t, s0)) = w;
    }
#pragma unroll 1
    for (int it = 0; it < 4; ++it) {
        const int l = it * 32 + wid * 4 + (lane & 3), ch = lane >> 2, tok = tok0 + l;
        const u32x4 raw = *(const u32x4*)(p + (size_t)tok * NP + 2560 + g * 128 + ch * 8); float x[8]; unpack8(raw, x);
        float s = ((x[0] + x[1]) + (x[2] + x[3])) + ((x[4] + x[5]) + (x[6] + x[7]));
        s += __shfl_xor(s, 4); s += __shfl_xor(s, 8); s += __shfl_xor(s, 16); s += __shfl_xor(s, 32);
        const float mu = s * (1.f / 128.f); float q = 0.f;
#pragma unroll
        for (int e = 0; e < 8; ++e) { x[e] -= mu; q += x[e] * x[e]; }
        q += __shfl_xor(q, 4); q += __shfl_xor(q, 8); q += __shfl_xor(q, 16); q += __shfl_xor(q, 32);
        const float rstd = rsqrtf(q * (1.f / 128.f) + LN_EPS);
        const float* nw = P.in[5] + g * 128 + ch * 8; const float* nb = P.in[6] + g * 128 + ch * 8;
#pragma unroll
        for (int e = 0; e < 8; ++e) Vst[swz(ch * 8 + e, l)] = f2bf(x[e] * rstd * nw[e] + nb[e]);
    }
    __syncthreads();
    f32x4 acc[8];
#pragma unroll
    for (int n = 0; n < 8; ++n) acc[n] = (f32x4){0.f, 0.f, 0.f, 0.f};
    wave_mm(Wl, Vst, acc, wid * 16, fr, fq, (wid >> 1) + 1, 8);
    { const int t = wid * 16 + fr, tok = tok0 + t; const float bsp = P.in[8][g * 128 + t];
      const bf16_t* up = p + (size_t)tok * NP + 2048 + g * 128 + fq * 4; bf16_t* yp = (bf16_t*)(ws + WS_Y) + (size_t)tok * DM + 512 + g * 128 + fq * 4;
#pragma unroll
      for (int n = 0; n < 8; ++n) { const u32x2 ur = *(const u32x2*)(up + n * 16);
          u32x2 w; w.x = cvt_pk_bf16(bflo(ur.x) * (acc[n][0] + bsp), bfhi(ur.x) * (acc[n][1] + bsp)); w.y = cvt_pk_bf16(bflo(ur.y) * (acc[n][2] + bsp), bfhi(ur.y) * (acc[n][3] + bsp));
          *(u32x2*)(yp + n * 16) = w; } }
    __syncthreads();
}

__device__ __forceinline__ void phase_scan(const Params& P) {
    unsigned char* ws = P.ws;
    const float* __restrict__ gt = (const float*)(ws + WS_SMALL + SM_GTOT); const float* __restrict__ ml = (const float*)(ws + WS_SMALL + SM_MLOC);
    const float* __restrict__ dC = (const float*)(ws + WS_DC); unsigned* __restrict__ Cp = (unsigned*)(ws + WS_CPREV);
    for (int idx = blockIdx.x * 512 + threadIdx.x; idx < 8 * 8192; idx += gridDim.x * 512) {
        const int bh = idx >> 13, e = (idx & 8191) * 2;
        float m = 0.f, c0 = 0.f, c1 = 0.f;
#pragma unroll 8
        for (int c = 0; c < 64; ++c) { const int task = bh * 64 + c;
            Cp[((size_t)task * 16384 + e) >> 1] = cvt_pk_bf16(c0, c1);
            const float g = gt[task], l = ml[task], mn = fmaxf(g + m, l), dec = __expf(g + m - mn), sc = __expf(l - mn);
            const f32x2 d = *(const f32x2*)(dC + (size_t)task * 16384 + e);
            c0 = dec * c0 + sc * d.x; c1 = dec * c1 + sc * d.y; m = mn; }
    }
    const float* __restrict__ dn = (const float*)(ws + WS_SMALL + SM_DN); float* __restrict__ np = (float*)(ws + WS_SMALL + SM_NPREV); float* __restrict__ mp = (float*)(ws + WS_SMALL + SM_MPREV);
    for (int idx = blockIdx.x * 512 + threadIdx.x; idx < 8 * 128; idx += gridDim.x * 512) {
        const int bh = idx >> 7, k = idx & 127;
        float m = 0.f, n = 0.f;
        for (int c = 0; c < 64; ++c) { const int task = bh * 64 + c;
            np[task * 128 + k] = n; if (k == 0) mp[task] = m;
            const float g = gt[task], l = ml[task], mn = fmaxf(g + m, l), dec = __expf(g + m - mn), sc = __expf(l - mn);
            n = dec * n + sc * dn[task * 128 + k]; m = mn; }
    }
}

__device__ __forceinline__ void mlstm_out(const Params& P, LAS unsigned char* lds, int task) {
    const int tid = threadIdx.x, lane = tid & 63, wid = __builtin_amdgcn_readfirstlane(tid >> 6), fr = lane & 15, fq = lane >> 4;
    const int bh = task >> 6, c = task & 63, b = bh >> 2, h = bh & 3, tok0 = b * SEQ + c * 128;
    unsigned char* ws = P.ws;
    LAS bf16_t* Ql = (LAS bf16_t*)lds; LAS bf16_t* Kl = (LAS bf16_t*)(lds + 32768); LAS bf16_t* Vt = (LAS bf16_t*)(lds + 65536); LAS bf16_t* Cl = (LAS bf16_t*)(lds + 98304);
    LAS float* ibl = (LAS float*)(lds + 131072); LAS float* mjl = ibl + 128; LAS float* al = ibl + 256; LAS float* rcl = ibl + 384; LAS float* nl = ibl + 512;
    const float* gates = (const float*)(ws + WS_GATES); const bf16_t* p = (const bf16_t*)(ws + WS_P);
    if (wid == 0) {
        const int l0 = 2 * lane;
        const float i0 = gates[(size_t)(tok0 + l0) * 8 + h], i1 = gates[(size_t)(tok0 + l0 + 1) * 8 + h];
        const float lf0 = logsigmoid(gates[(size_t)(tok0 + l0) * 8 + 4 + h]), lf1 = logsigmoid(gates[(size_t)(tok0 + l0 + 1) * 8 + 4 + h]);
        const float s1 = lf0 + lf1; float tot = s1;
#pragma unroll
        for (int o = 1; o < 64; o <<= 1) { const float t = __shfl_up(tot, o); if (lane >= o) tot += t; }
        const float ex = tot - s1, b0 = ex + lf0, b1 = ex + s1;
        const float ib0 = i0 - b0, ib1 = i1 - b1; const float pl = fmaxf(ib0, ib1); float pm = pl;
#pragma unroll
        for (int o = 1; o < 64; o <<= 1) { const float t = __shfl_up(pm, o); if (lane >= o) pm = fmaxf(pm, t); }
        float pex = __shfl_up(pm, 1); if (lane == 0) pex = -INFINITY;
        const float pm0 = fmaxf(pex, ib0), pm1 = fmaxf(pex, pl);
        const float mprev = ((const float*)(ws + WS_SMALL + SM_MPREV))[task];
        const float mj0 = b0 + fmaxf(mprev, pm0), mj1 = b1 + fmaxf(mprev, pm1);
        ibl[l0] = ib0; ibl[l0 + 1] = ib1; mjl[l0] = mj0; mjl[l0 + 1] = mj1;
        al[l0] = __expf(b0 + mprev - mj0); al[l0 + 1] = __expf(b1 + mprev - mj1); rcl[l0] = b0 - mj0; rcl[l0 + 1] = b1 - mj1;
    } else if (wid == 1) {
        nl[lane] = ((const float*)(ws + WS_SMALL + SM_NPREV))[task * 128 + lane]; nl[lane + 64] = ((const float*)(ws + WS_SMALL + SM_NPREV))[task * 128 + lane + 64];
    }
#pragma unroll 1
    for (int it = 0; it < 4; ++it) {
        const int l = it * 32 + wid * 4 + (lane & 3), ch = lane >> 2, tok = tok0 + l, pos = c * 128 + l;
        float y[8];
        conv_silu8(p + (size_t)tok * NP + h * 128 + ch * 8, P.in[3] + h * 128 + ch * 8, pos, y);
        { u32x4 w; w.x = cvt_pk_bf16(y[0], y[1]); w.y = cvt_pk_bf16(y[2], y[3]); w.z = cvt_pk_bf16(y[4], y[5]); w.w = cvt_pk_bf16(y[6], y[7]); *(LAS u32x4*)(Ql + swz(l, ch * 8)) = w; }
        conv_silu8(p + (size_t)tok * NP + 512 + h * 128 + ch * 8, P.in[3] + 512 + h * 128 + ch * 8, pos, y);
        { const float sc = 0.08838834764831845f; u32x4 w; w.x = cvt_pk_bf16(y[0] * sc, y[1] * sc); w.y = cvt_pk_bf16(y[2] * sc, y[3] * sc); w.z = cvt_pk_bf16(y[4] * sc, y[5] * sc); w.w = cvt_pk_bf16(y[6] * sc, y[7] * sc);
          *(LAS u32x4*)(Kl + swz(l, ch * 8)) = w; }
        const u32x4 raw = *(const u32x4*)(p + (size_t)tok * NP + 1024 + h * 128 + ch * 8);
        Vt[swz(ch * 8 + 0, l)] = (bf16_t)(raw.x & 0xffffu); Vt[swz(ch * 8 + 1, l)] = (bf16_t)(raw.x >> 16);
        Vt[swz(ch * 8 + 2, l)] = (bf16_t)(raw.y & 0xffffu); Vt[swz(ch * 8 + 3, l)] = (bf16_t)(raw.y >> 16);
        Vt[swz(ch * 8 + 4, l)] = (bf16_t)(raw.z & 0xffffu); Vt[swz(ch * 8 + 5, l)] = (bf16_t)(raw.z >> 16);
        Vt[swz(ch * 8 + 6, l)] = (bf16_t)(raw.w & 0xffffu); Vt[swz(ch * 8 + 7, l)] = (bf16_t)(raw.w >> 16);
        const int i = it * 512 + tid, v = i >> 4, kb = i & 15;
        *(LAS u32x4*)(Cl + swz(v, kb * 8)) = *(const u32x4*)((const bf16_t*)(ws + WS_CPREV) + (size_t)task * 16384 + v * 128 + kb * 8);
    }
    __syncthreads();
    const int l = wid * 16 + fr;
    f32x4 acc[8];
#pragma unroll
    for (int n = 0; n < 8; ++n) acc[n] = (f32x4){0.f, 0.f, 0.f, 0.f};
    wave_mm(Ql, Kl, acc, wid * 16, fr, fq, 4, wid + 1);
    const float rc = rcl[l];
    float rs = 0.f;
#pragma unroll
    for (int n = 0; n < 8; ++n) {
#pragma unroll
        for (int j = 0; j < 4; ++j) { const int s = n * 16 + fq * 4 + j; const float w = (s <= l) ? __expf(rc + ibl[s]) : 0.f; const float v = acc[n][j] * w; acc[n][j] = v; rs += v; } }
    rs += __shfl_xor(rs, 16); rs += __shfl_xor(rs, 32);
    float nq = 0.f;
#pragma unroll
    for (int blk = 0; blk < 4; ++blk) { const int kb = fq * 4 + blk; const u32x4 r = *(const LAS u32x4*)(Ql + swz(l, kb * 8)); float x[8]; unpack8(r, x);
#pragma unroll
        for (int e = 0; e < 8; ++e) nq += x[e] * nl[kb * 8 + e]; }
    nq += __shfl_xor(nq, 16); nq += __shfl_xor(nq, 32);
    __syncthreads();
#pragma unroll
    for (int n = 0; n < 8; ++n) { u32x2 w; w.x = cvt_pk_bf16(acc[n][0], acc[n][1]); w.y = cvt_pk_bf16(acc[n][2], acc[n][3]); *(LAS u32x2*)(Kl + swz(l, n * 16 + fq * 4)) = w; }
    __syncthreads();
    const float a = al[l], mj = mjl[l];
#pragma unroll
    for (int n = 0; n < 8; ++n) acc[n] = (f32x4){0.f, 0.f, 0.f, 0.f};
    wave_mm(Ql, Cl, acc, wid * 16, fr, fq, 4, 8);
#pragma unroll
    for (int n = 0; n < 8; ++n) acc[n] *= a;
    wave_mm(Kl, Vt, acc, wid * 16, fr, fq, (wid >> 1) + 1, 8);
    const float den = rs + a * nq, hd = fmaxf(fabsf(den), __expf(-mj)), inv = 1.f / hd;
    float sum = 0.f;
#pragma unroll
    for (int n = 0; n < 8; ++n) { acc[n] *= inv; sum += (acc[n][0] + acc[n][1]) + (acc[n][2] + acc[n][3]); }
    sum += __shfl_xor(sum, 16); sum += __shfl_xor(sum, 32);
    const float mu = sum * (1.f / 128.f); float q = 0.f;
#pragma unroll
    for (int n = 0; n < 8; ++n) { acc[n] -= mu; q += (acc[n][0] * acc[n][0] + acc[n][1] * acc[n][1]) + (acc[n][2] * acc[n][2] + acc[n][3] * acc[n][3]); }
    q += __shfl_xor(q, 16); q += __shfl_xor(q, 32);
    const float rstd = rsqrtf(q * (1.f / 128.f) + LN_EPS);
    { const int tok = tok0 + l; const bf16_t* og = p + (size_t)tok * NP + 1536 + h * 128 + fq * 4; const float* nw = P.in[4] + h * 128 + fq * 4;
      bf16_t* yp = (bf16_t*)(ws + WS_Y) + (size_t)tok * DM + h * 128 + fq * 4;
#pragma unroll
      for (int n = 0; n < 8; ++n) { const u32x2 orw = *(const u32x2*)(og + n * 16); const f32x4 w4 = *(const f32x4*)(nw + n * 16);
          const float o0 = 1.f / (1.f + __expf(-bflo(orw.x))), o1 = 1.f / (1.f + __expf(-bfhi(orw.x))), o2 = 1.f / (1.f + __expf(-bflo(orw.y))), o3 = 1.f / (1.f + __expf(-bfhi(orw.y)));
          u32x2 w; w.x = cvt_pk_bf16(o0 * acc[n][0] * rstd * w4[0], o1 * acc[n][1] * rstd * w4[1]); w.y = cvt_pk_bf16(o2 * acc[n][2] * rstd * w4[2], o3 * acc[n][3] * rstd * w4[3]);
          *(u32x2*)(yp + n * 16) = w; } }
    __syncthreads();
}

__device__ __forceinline__ void phase_ln(const float* in, float* outf, bf16_t* outb, const float* w, const float* bsrc) {
    const int lane = threadIdx.x & 63, wid = threadIdx.x >> 6;
    f32x4 wv[4], bv[4];
#pragma unroll
    for (int i = 0; i < 4; ++i) { wv[i] = *(const f32x4*)(w + (i * 64 + lane) * 4); bv[i] = *(const f32x4*)(bsrc + (i * 64 + lane) * 4); }
    for (int row = blockIdx.x * 8 + wid; row < T_TOK; row += gridDim.x * 8) {
        const f32x4* xr = (const f32x4*)(in + (size_t)row * DM); f32x4 v[4]; float s = 0.f;
#pragma unroll
        for (int i = 0; i < 4; ++i) { v[i] = xr[i * 64 + lane]; s += (v[i][0] + v[i][1]) + (v[i][2] + v[i][3]); }
#pragma unroll
        for (int o = 32; o >= 1; o >>= 1) s += __shfl_xor(s, o);
        const float mu = s * (1.f / 1024.f); float q = 0.f;
#pragma unroll
        for (int i = 0; i < 4; ++i) { v[i] -= mu; q += (v[i][0] * v[i][0] + v[i][1] * v[i][1]) + (v[i][2] * v[i][2] + v[i][3] * v[i][3]); }
#pragma unroll
        for (int o = 32; o >= 1; o >>= 1) q += __shfl_xor(q, o);
        const float rstd = rsqrtf(q * (1.f / 1024.f) + LN_EPS);
#pragma unroll
        for (int i = 0; i < 4; ++i) { const f32x4 y = v[i] * rstd * wv[i] + bv[i];
            *(f32x4*)(outf + (size_t)row * DM + (i * 64 + lane) * 4) = y;
            if (outb) { u32x2 pk; pk.x = cvt_pk_bf16(y[0], y[1]); pk.y = cvt_pk_bf16(y[2], y[3]); *(u32x2*)(outb + (size_t)row * DM + (i * 64 + lane) * 4) = pk; } }
    }
}

__global__ void __launch_bounds__(512, 2) fwd_megakernel(Params P) {
    extern __shared__ __attribute__((aligned(16))) unsigned char shm[];
    LAS unsigned char* lds = (LAS unsigned char*)shm;
    cg::grid_group grid = cg::this_grid();
    unsigned char* ws = P.ws;
    const int G = (int)gridDim.x, bx = (int)blockIdx.x;

#ifndef NO_PREP
    phase_prep(P, lds);
#endif
    grid.sync();
#ifndef NO_G1
    { pg8::Gemm g{(const bf16_t*)(ws + WS_XB), (const bf16_t*)(ws + WS_WINT), T_TOK, NP, DM}; pg8::StaticOrder S; S.init(T_TOK, NP, G, bx); EpiP E{(bf16_t*)(ws + WS_P)};
      pg8::gemm_phase<EpiP, pg8::StaticOrder, false>(lds, g, S, E, nullptr); }
#endif
    grid.sync();
#ifndef NO_P2
    for (int task = bx; task < 1024; task += G) { if (task < 512) mlstm_local(P, lds, task); else sgu_task(P, lds, task - 512); }
#endif
    grid.sync();
#ifndef NO_P3
    phase_scan(P);
#endif
    grid.sync();
#ifndef NO_P4
    for (int task = bx; task < 512; task += G) mlstm_out(P, lds, task);
#endif
    grid.sync();
#ifndef NO_G2
    { pg8::Gemm g{(const bf16_t*)(ws + WS_Y), (const bf16_t*)(ws + WS_WOUTT), T_TOK, DM, DM}; pg8::StaticOrder S; S.init(T_TOK, DM, G, bx); EpiRes E{(float*)(ws + WS_R1), P.in[0]};
      pg8::gemm_phase<EpiRes, pg8::StaticOrder, false>(lds, g, S, E, nullptr); }
#endif
    grid.sync();
    phase_ln((const float*)(ws + WS_R1), (float*)(ws + WS_R1), (bf16_t*)(ws + WS_H1B), P.in[10], P.in[11]);
    grid.sync();
#ifndef NO_G3
    { pg8::Gemm g{(const bf16_t*)(ws + WS_H1B), (const bf16_t*)(ws + WS_WGUT), T_TOK, 2 * DFF, DM}; pg8::StaticOrder S; S.init(T_TOK, 2 * DFF, G, bx); EpiSwiglu E{(bf16_t*)(ws + WS_HDN)};
      pg8::gemm_phase<EpiSwiglu, pg8::StaticOrder, false>(lds, g, S, E, nullptr); }
#endif
    grid.sync();
#ifndef NO_G4
    { pg8::Gemm g{(const bf16_t*)(ws + WS_HDN), (const bf16_t*)(ws + WS_WDOWNT), T_TOK, DM, DFF}; pg8::StaticOrder S; S.init(T_TOK, DM, G, bx); EpiRes E{P.out, (const float*)(ws + WS_R1)};
      pg8::gemm_phase<EpiRes, pg8::StaticOrder, false>(lds, g, S, E, nullptr); }
#endif
    grid.sync();
    phase_ln(P.out, P.out, nullptr, P.in[15], P.in[16]);
}

extern "C" void kernel_launch(void* const* d_in, const int* in_sizes, int n_in, void* d_out, int out_size, void* d_ws, size_t ws_size, hipStream_t stream) {
    (void)in_sizes; (void)n_in; (void)out_size; (void)ws_size;
    static int grid_blocks = 0;
    if (!grid_blocks) {
        int dev = 0, cus = 0, per_cu = 0;
        hipGetDevice(&dev);
        hipDeviceGetAttribute(&cus, hipDeviceAttributeMultiprocessorCount, dev);
        if (hipFuncSetAttribute((const void*)fwd_megakernel, hipFuncAttributeMaxDynamicSharedMemorySize, LDS_BYTES) != hipSuccess) fprintf(stderr, "hipFuncSetAttribute failed\n");
        if (hipOccupancyMaxActiveBlocksPerMultiprocessor(&per_cu, (const void*)fwd_megakernel, 512, LDS_BYTES) != hipSuccess || per_cu < 1) { fprintf(stderr, "occupancy query failed\n"); per_cu = 1; }
        if (per_cu > 1) per_cu = 1;
        grid_blocks = cus * per_cu;
    }
    Params P{};
    for (int i = 0; i < 17; ++i) P.in[i] = (const float*)d_in[i];
    P.out = (float*)d_out; P.ws = (unsigned char*)d_ws;
    void* args[] = {&P};
    hipError_t e = hipLaunchCooperativeKernel((const void*)fwd_megakernel, dim3(grid_blocks), dim3(512), args, LDS_BYTES, stream);
    if (e != hipSuccess) fprintf(stderr, "cooperative launch failed: %s (grid %d)\n", hipGetErrorString(e), grid_blocks);
}
```

```cpp
#include <hip/hip_runtime.h>
#include <hip/hip_cooperative_groups.h>
#include <cstdio>
#include <cstddef>
namespace cg = cooperative_groups;
namespace pg8 {
#define PG8_LAS __attribute__((address_space(3)))
typedef unsigned short bf16_t;
typedef short bf16x8 __attribute__((ext_vector_type(8)));
typedef float f32x4 __attribute__((ext_vector_type(4)));
typedef unsigned u32x4 __attribute__((ext_vector_type(4)));
constexpr int BM = 256, BK = 64, HALF = 128, HTB = HALF * BK * 2  , STAGE_BYTES = 8 * HTB, NXCD = 8, WGM = 8;

__host__ __device__ __forceinline__ int lds_byte(int r, int c) { const int st = (r >> 4) * 2 + (c >> 5), rr = r & 15, cc = c & 31, ob = rr * 64 + cc * 2; return st * 1024 + (ob ^ (((ob >> 9) & 1) << 5)); }
__host__ __device__ __forceinline__ void stage_rc(int b, int& R, int& C) { const int st = b / 1024, sb = b % 1024, swz = sb ^ (((sb >> 9) & 1) << 5); R = (st >> 1) * 16 + swz / 64; C = (st & 1) * 32 + (swz % 64) / 2; }
__host__ __device__ __forceinline__ int perm32(int rho) { const int n = rho >> 4, i = rho & 15; return 8 * (i >> 2) + 4 * n + (i & 3); }

struct Unit { int pm, pn; };
struct Gemm { const bf16_t* A; const bf16_t* Bt; int M, N, K; };

struct StaticOrder {
    int nM, nN, nwg, G, c;
    __host__ __device__ void init(int M, int N, int G_, int c_) { nM = M / BM; nN = N / BM; nwg = nM * nN; G = G_; c = c_; }
    __host__ __device__ bool next(int i, Unit& u) const {
        const long L = (long)i * G + c; if (L >= nwg) return false;
        int wgid = (int)L; { const int q = nwg / NXCD, r = nwg % NXCD, xcd = wgid % NXCD, off = wgid / NXCD; wgid = (xcd < r ? xcd * (q + 1) : r * (q + 1) + (xcd - r) * q) + off; }
        const int nig = WGM * nN, gid = wgid / nig, fm = gid * WGM, gsz = (nM - fm) < WGM ? (nM - fm) : WGM;
        u.pm = fm + ((wgid % nig) % gsz); u.pn = (wgid % nig) / gsz; return true;
    }
    __device__ __forceinline__ void a_ready(const Unit&) const {}
    __device__ __forceinline__ void done(const Unit&) const {}
};
struct CountedOrder : StaticOrder {
    const unsigned* ready; unsigned need; unsigned* tmo;
    __device__ __forceinline__ void a_ready(const Unit& u) const {
        if (threadIdx.x < 64) {
            const unsigned long long t0 = __builtin_amdgcn_s_memrealtime(); unsigned polls = 0;
            while ((unsigned)__builtin_amdgcn_readfirstlane(__hip_atomic_load(ready + 64 * u.pm, __ATOMIC_RELAXED, __HIP_MEMORY_SCOPE_AGENT)) < need) {
                if ((++polls & 255u) == 0u && __builtin_amdgcn_readfirstlane(__hip_atomic_load(tmo, __ATOMIC_RELAXED, __HIP_MEMORY_SCOPE_AGENT)) != 0u) break;
                if (__builtin_amdgcn_s_memrealtime() - t0 > 2000000ull) {
                    if (threadIdx.x == 0) { unsigned expect = 0u; __hip_atomic_compare_exchange_strong(tmo + 1, &expect, 0x600u | (unsigned)(u.pm & 0xff), __ATOMIC_RELAXED, __ATOMIC_RELAXED, __HIP_MEMORY_SCOPE_AGENT); __hip_atomic_store(tmo, 1u, __ATOMIC_RELAXED, __HIP_MEMORY_SCOPE_AGENT); }
                    break; }
                __builtin_amdgcn_s_sleep(2); }
            __builtin_amdgcn_fence(__ATOMIC_ACQUIRE, "agent");
            asm volatile("s_waitcnt vmcnt(0)" ::: "memory");
        }
#if !defined(BROKEN_HOOK_NO_BARRIER)
        asm volatile("" ::: "memory"); __builtin_amdgcn_s_barrier(); asm volatile("" ::: "memory");
#endif
    }
};

__device__ __forceinline__ unsigned cvt_pk_bf16(float lo, float hi) { unsigned r; asm volatile("v_cvt_pk_bf16_f32 %0, %1, %2" : "=v"(r) : "v"(lo), "v"(hi)); return r; }
typedef float f32x2 __attribute__((ext_vector_type(2)));
__device__ __forceinline__ f32x2 gelu_pk(f32x2 v) {
    const f32x2 av = __builtin_elementwise_abs(v), d = av * 0.2316418882f + 1.0f;
    f32x2 t; t.x = __builtin_amdgcn_rcpf(d.x); t.y = __builtin_amdgcn_rcpf(d.y);
    f32x2 q = t * 0.5307027145f + (-0.7265760135f); q = q * t + 0.7107068705f; q = q * t + (-0.142248368f); q = q * t + 0.127414796f; q = q * t;
    const f32x2 s = (v * v) * (-0.72134752044f);
    f32x2 e; e.x = __builtin_amdgcn_exp2f(s.x); e.y = __builtin_amdgcn_exp2f(s.y);
    const f32x2 m = v * (q * e), r = v - m;
    f32x2 o; o.x = v.x < 0.f ? m.x : r.x; o.y = v.y < 0.f ? m.y : r.y; return o;
}

template <class Epi, class Sched, bool STAMP = false>
__device__ __forceinline__ void gemm_phase(PG8_LAS unsigned char* lds, const Gemm g, const Sched& S, const Epi& E, unsigned long long* stamps) {
    const int tid = threadIdx.x, wid = __builtin_amdgcn_readfirstlane(tid >> 6), lane = tid & 63, wr = wid >> 2, wc = wid & 3, fr = lane & 15, fq = lane >> 4;
    const int K = g.K, nt = K / BK;
    int ts_lo = 0, ts_hi = 0, nts = 0; const unsigned long long rt_entry = STAMP ? (unsigned long long)wall_clock64() : 0ull;
#define PG8_STAMP() do { if (STAMP && wid == 0 && nts < 64) { const unsigned long long _c = (unsigned long long)clock64(); \
        ts_lo = (lane == nts) ? (int)(unsigned)_c : ts_lo; ts_hi = (lane == nts) ? (int)(unsigned)(_c >> 32) : ts_hi; ++nts; } } while (0)
    PG8_STAMP();
    unsigned voffA[2], voffB[2];
#pragma unroll
    for (int i = 0; i < 2; ++i) { int R, C; stage_rc(tid * 16 + i * 8192, R, C); const int Rb = Epi::PERM ? ((R & ~31) + perm32(R & 31)) : R;
        voffA[i] = (unsigned)(R * K + C) * 2u; voffB[i] = (unsigned)(Rb * K + C) * 2u; }
    const size_t kstep = (size_t)(BK * 2);
    const size_t hstep = (size_t)HALF * K * 2;
    const size_t tstep = 2 * hstep;
    const unsigned ldsw = (unsigned)wid * 1024u;
    const int aoff = lds_byte(wr * 64 + fr, fq * 8), boff = lds_byte(wc * 32 + fr, fq * 8);
#define PG8_SA(b, h) (((b) * 2 + (h)) * HTB)
#define PG8_SB(b, h) ((4 + (b) * 2 + (h)) * HTB)
#define PG8_STAGE(bufoff, gbase, voff) do { _Pragma("unroll") for (int _i = 0; _i < 2; ++_i) \
        __builtin_amdgcn_global_load_lds((const unsigned*)((const char*)(gbase) + (voff)[_i]), (PG8_LAS unsigned*)(lds + (bufoff) + ldsw + _i * 8192), 16, 0, 0); } while (0)
#define PG8_LDA(dst, b, h) do { _Pragma("unroll") for (int m = 0; m < 4; ++m) _Pragma("unroll") for (int k = 0; k < 2; ++k) dst[m][k] = *(const PG8_LAS bf16x8*)(lds + PG8_SA(b, h) + aoff + m * 2048 + k * 1024); } while (0)
#define PG8_LDB(dst, b, h) do { _Pragma("unroll") for (int n = 0; n < 2; ++n) _Pragma("unroll") for (int k = 0; k < 2; ++k) dst[n][k] = *(const PG8_LAS bf16x8*)(lds + PG8_SB(b, h) + boff + n * 2048 + k * 1024); } while (0)
#define PG8_MMA(ai, bj, At, Bt) do { __builtin_amdgcn_s_setprio(1); _Pragma("unroll") for (int m = 0; m < 4; ++m) _Pragma("unroll") for (int n = 0; n < 2; ++n) _Pragma("unroll") for (int k = 0; k < 2; ++k) \
        acc[ai][bj][m][n] = __builtin_amdgcn_mfma_f32_16x16x32_bf16(Bt[n][k], At[m][k], acc[ai][bj][m][n], 0, 0, 0); __builtin_amdgcn_s_setprio(0); } while (0)
#define PG8_WAIT_V(n) asm volatile("s_waitcnt vmcnt(" #n ")" ::: "memory")
#define PG8_WAIT_L(n) asm volatile("s_waitcnt lgkmcnt(" #n ")" ::: "memory")
#define PG8_BAR __builtin_amdgcn_s_barrier()
#define PG8_SCHED __builtin_amdgcn_sched_barrier(0)
    Unit cur, nxt; int ui = 0;
    if (!S.next(0, cur)) return;
    f32x4 acc[2][2][4][2];
#pragma unroll
    for (int a = 0; a < 2; ++a)
#pragma unroll
        for (int b = 0; b < 2; ++b)
#pragma unroll
            for (int m = 0; m < 4; ++m)
#pragma unroll
                for (int n = 0; n < 2; ++n) acc[a][b][m][n] = (f32x4){0.f, 0.f, 0.f, 0.f};
    bf16x8 At[4][2], B0[2][2], B1[2][2];
    const char* cA = (const char*)g.A + (size_t)cur.pm * tstep; const char* cB = (const char*)g.Bt + (size_t)cur.pn * tstep;
    S.a_ready(cur);
    PG8_STAGE(PG8_SB(0, 0), cB, voffB); PG8_STAGE(PG8_SA(0, 0), cA, voffA); PG8_STAGE(PG8_SB(0, 1), cB + hstep, voffB); PG8_STAGE(PG8_SA(0, 1), cA + hstep, voffA);
    if (wr == 1) PG8_BAR;
    PG8_WAIT_V(4); PG8_BAR;
    PG8_STAGE(PG8_SB(1, 0), cB + kstep, voffB); PG8_STAGE(PG8_SA(1, 0), cA + kstep, voffA); PG8_STAGE(PG8_SB(1, 1), cB + hstep + kstep, voffB);
    PG8_WAIT_V(6); PG8_BAR;
    PG8_STAMP();
    for (;;) {
        const bool has_next = S.next(ui + 1, nxt);
        const char* nA = has_next ? (const char*)g.A + (size_t)nxt.pm * tstep : cA; const char* nB = has_next ? (const char*)g.Bt + (size_t)nxt.pn * tstep : cB;
        for (int t = 0; t < nt; t += 2) {
            const bool last = (t == nt - 2);
            const char* a1 = cA + (size_t)(t + 1) * kstep;
            const char* a2 = last ? nA : cA + (size_t)(t + 2) * kstep; const char* b2 = last ? nB : cB + (size_t)(t + 2) * kstep;
            const char* a3 = a2 + kstep; const char* b3 = b2 + kstep;
            if (last && has_next) S.a_ready(nxt);
            PG8_LDB(B0, 0, 0); PG8_SCHED; PG8_LDA(At, 0, 0); PG8_STAGE(PG8_SA(1, 1), a1 + hstep, voffA);
            PG8_WAIT_L(8); PG8_BAR; PG8_WAIT_L(0); PG8_MMA(0, 0, At, B0); PG8_BAR; PG8_SCHED;
            PG8_LDB(B1, 0, 1); PG8_STAGE(PG8_SB(0, 0), b2, voffB);
            PG8_BAR; PG8_WAIT_L(0); PG8_MMA(0, 1, At, B1); PG8_BAR;
            PG8_LDA(At, 0, 1); PG8_STAGE(PG8_SA(0, 0), a2, voffA);
            PG8_BAR; PG8_WAIT_L(0); PG8_MMA(1, 0, At, B0); PG8_BAR; PG8_SCHED;
            PG8_STAGE(PG8_SB(0, 1), b2 + hstep, voffB);
            PG8_WAIT_V(6); PG8_BAR; PG8_MMA(1, 1, At, B1); PG8_BAR;
            PG8_LDB(B0, 1, 0); PG8_SCHED; PG8_LDA(At, 1, 0); PG8_STAGE(PG8_SA(0, 1), a2 + hstep, voffA);
            PG8_WAIT_L(8); PG8_BAR; PG8_WAIT_L(0); PG8_MMA(0, 0, At, B0); PG8_BAR; PG8_SCHED;
            PG8_LDB(B1, 1, 1); PG8_STAGE(PG8_SB(1, 0), b3, voffB);
            PG8_BAR; PG8_WAIT_L(0); PG8_MMA(0, 1, At, B1); PG8_BAR;
            PG8_LDA(At, 1, 1); PG8_STAGE(PG8_SA(1, 0), a3, voffA);
            PG8_BAR; PG8_WAIT_L(0); PG8_MMA(1, 0, At, B0); PG8_BAR; PG8_SCHED;
            PG8_STAGE(PG8_SB(1, 1), b3 + hstep, voffB);
            PG8_WAIT_V(6); PG8_BAR; PG8_MMA(1, 1, At, B1); PG8_BAR;
        }
        PG8_STAMP();
        if constexpr (!Epi::AFTER_DRAIN) { E(acc, cur, wr, wc, fr, fq); S.done(cur); }
        PG8_STAMP();
        if (!has_next) break;
#pragma unroll
        for (int a = 0; a < 2; ++a)
#pragma unroll
            for (int b = 0; b < 2; ++b)
#pragma unroll
                for (int m = 0; m < 4; ++m)
#pragma unroll
                    for (int n = 0; n < 2; ++n) acc[a][b][m][n] = (f32x4){0.f, 0.f, 0.f, 0.f};
        cur = nxt; cA = nA; cB = nB; ++ui;
    }
    PG8_WAIT_V(0);
    if (wr == 0) PG8_BAR;
    PG8_BAR;
    if constexpr (Epi::AFTER_DRAIN) { E.fused(acc, cur, wr, wc, fr, fq, lds, wid, lane); S.done(cur); }
    PG8_STAMP();
    if (STAMP && wid == 0) { stamps[lane] = lane < nts ? (((unsigned long long)(unsigned)ts_hi << 32) | (unsigned)ts_lo) : 0ull;
        if (lane == 62) stamps[62] = rt_entry; if (lane == 63) stamps[63] = (unsigned long long)wall_clock64(); }
#undef PG8_STAMP
#undef PG8_SA
#undef PG8_SB
#undef PG8_STAGE
#undef PG8_LDA
#undef PG8_LDB
#undef PG8_MMA
#undef PG8_WAIT_V
#undef PG8_WAIT_L
#undef PG8_BAR
#undef PG8_SCHED
}
}
#define XB_TMO      128
#define XB_XCNT(j)  (256  + 64 * (j))
#define XB_XSUB(j)  (1280 + 64 * (j))
#define XB_XGEN(j)  (2304 + 64 * (j))
#define XB_TOP      3328
#define XB_TOPGEN   3392
#define XCD_BAR_WORDS 3456
#define XB_SPIN_CAP (1u << 18)
#ifndef LAS
#define LAS __attribute__((address_space(3)))
#endif

__device__ __forceinline__ unsigned xb_ld(unsigned* p)              { return __hip_atomic_load(p, __ATOMIC_RELAXED, __HIP_MEMORY_SCOPE_AGENT); }
__device__ __forceinline__ unsigned xb_add(unsigned* p, unsigned v) { return __hip_atomic_fetch_add(p, v, __ATOMIC_RELAXED, __HIP_MEMORY_SCOPE_AGENT); }
__device__ __forceinline__ unsigned xb_xcc_id() { return (unsigned)__builtin_amdgcn_s_getreg((3 << 11) | 20) & 0xFu; }
#define XB_SPIN(cond, bar) do { unsigned _sp = 0; while (cond) { __builtin_amdgcn_s_sleep(1); \
    if ((++_sp & 255u) == 0u) { if (xb_ld(&(bar)[XB_TMO])) break; if (_sp > XB_SPIN_CAP) { atomicAdd(&(bar)[XB_TMO], 1u); break; } } } } while (0)

struct XcdBarrier {
    unsigned* bar; unsigned x;
    volatile LAS unsigned* st;
};

__device__ __forceinline__ XcdBarrier xcd_barrier_post(unsigned* bar, volatile LAS unsigned* st) {
    XcdBarrier b; b.bar = bar; b.x = xb_xcc_id(); b.st = st;
    if (threadIdx.x == 0) (void)xb_add(&bar[XB_XCNT(b.x)], 1u);
    return b;
}
__device__ __forceinline__ void xcd_barrier_complete(unsigned* bar, unsigned x, unsigned& nloc, unsigned& nx) {
    const unsigned G = gridDim.x * gridDim.y * gridDim.z;
    unsigned sum, cnt, mine, sp = 0u;
    for (;;) {
        sum = 0u; cnt = 0u; mine = 0u;
#pragma unroll
        for (unsigned j = 0; j < 16; ++j) { const unsigned c = xb_ld(&bar[XB_XCNT(j)]); sum += c; cnt += (c > 0u) ? 1u : 0u; mine = (j == x) ? c : mine; }
        if (sum == G) break;
        __builtin_amdgcn_s_sleep(1);
        if ((++sp & 255u) == 0u) { if (xb_ld(&bar[XB_TMO])) break; if (sp > XB_SPIN_CAP) { atomicAdd(&bar[XB_TMO], 1u); break; } }
    }
    nloc = mine > 0u ? mine : 1u; nx = cnt > 0u ? cnt : 1u;
}

__device__ __forceinline__ void xcd_barrier(const XcdBarrier& b) {
    asm volatile("s_waitcnt vmcnt(0)" ::: "memory");
    __syncthreads();
    if (threadIdx.x == 0) {
        unsigned* bar = b.bar;
        __builtin_amdgcn_s_waitcnt(0);
        unsigned nloc = b.st[0], nx = b.st[1];
        if (nloc == 0u) { xcd_barrier_complete(bar, b.x, nloc, nx); b.st[0] = nloc; b.st[1] = nx; }
        const unsigned old = xb_add(&bar[XB_XSUB(b.x)], 1u);
        const unsigned gen = old / nloc;
        if (old + 1u == (gen + 1u) * nloc) {
            __builtin_amdgcn_fence(__ATOMIC_RELEASE, "agent");
            asm volatile("s_waitcnt vmcnt(0)" ::: "memory");
            const unsigned og = xb_add(&bar[XB_TOP], 1u);
            const unsigned tg = og / nx;
            if (og + 1u == (tg + 1u) * nx) xb_add(&bar[XB_TOPGEN], 1u);
            else XB_SPIN(xb_ld(&bar[XB_TOPGEN]) == tg, bar);
            __builtin_amdgcn_fence(__ATOMIC_ACQUIRE, "agent");
            xb_add(&bar[XB_XGEN(b.x)], 1u);
            asm volatile("s_waitcnt vmcnt(0)" ::: "memory");
        } else {
            XB_SPIN(xb_ld(&bar[XB_XGEN(b.x)]) == gen, bar);
            __builtin_amdgcn_fence(__ATOMIC_ACQUIRE, "agent");
            asm volatile("s_waitcnt vmcnt(0)" ::: "memory");
        }
    }
    __syncthreads();
}


using pg8::bf16_t; using pg8::bf16x8; using pg8::f32x4; using pg8::u32x4; using pg8::f32x2; using pg8::cvt_pk_bf16;
#define LAS __attribute__((address_space(3)))
typedef unsigned u32x2 __attribute__((ext_vector_type(2)));

constexpr int T_TOK = 16384, DM = 1024, SEQ = 8192, NP = 3072, DFF = 2816, NIN = 3080;
constexpr float ALPHA = 1.189207115002721f;
constexpr float LN_EPS = 1e-5f;
constexpr size_t MiB = (size_t)1 << 20;
constexpr size_t WS_WINT = 0, WS_WOUTT = 6 * MiB, WS_WGUT = 8 * MiB, WS_WDOWNT = 19 * MiB, WS_GATES = 24 * MiB + 512 * 1024, WS_SMALL = 25 * MiB,
                 WS_P = 26 * MiB, WS_XB = 122 * MiB, WS_DC = 122 * MiB, WS_CPREV = 154 * MiB, WS_Y = 170 * MiB, WS_R1 = 26 * MiB, WS_H1B = 90 * MiB, WS_HDN = 122 * MiB, WS_QC = 202 * MiB, WS_KC = 218 * MiB;
constexpr size_t SM_DN = 0, SM_NPREV = 256 * 1024, SM_MLOC = 512 * 1024, SM_GTOT = 512 * 1024 + 2048, SM_MPREV = 512 * 1024 + 4096;
constexpr int LDS_BYTES = 136 * 1024;
constexpr size_t WS_BAR = 25 * MiB + 768 * 1024;

struct Params { const float* in[17]; float* out; unsigned char* ws; };

__device__ __forceinline__ float bflo(unsigned w) { return __uint_as_float(w << 16); }
__device__ __forceinline__ float bfhi(unsigned w) { return __uint_as_float(w & 0xffff0000u); }
__device__ __forceinline__ unsigned short f2bf(float f) { unsigned u = __float_as_uint(f); u += 0x7fffu + ((u >> 16) & 1u); return (unsigned short)(u >> 16); }
__device__ __forceinline__ void unpack8(const u32x4 r, float (&x)[8]) {
    x[0] = bflo(r.x); x[1] = bfhi(r.x); x[2] = bflo(r.y); x[3] = bfhi(r.y); x[4] = bflo(r.z); x[5] = bfhi(r.z); x[6] = bflo(r.w); x[7] = bfhi(r.w); }
__device__ __forceinline__ float logsigmoid(float f) { return fminf(f, 0.f) - log1pf(expf(-fabsf(f))); }
__device__ __forceinline__ float siluf(float y) { return y / (1.f + __expf(-y)); }
__device__ __forceinline__ int swz(int r, int c) { return r * 128 + ((((c >> 3) ^ r ^ (r >> 3)) & 15) << 3) + (c & 7); }

__device__ __forceinline__ void wave_mm(const LAS bf16_t* A, const LAS bf16_t* B, f32x4 (&acc)[8], int row0, int fr, int fq, int nks, int ntiles) {
#pragma unroll 1
    for (int kk = 0; kk < nks; ++kk) {
        int frl = fr; asm volatile("" : "+v"(frl));
        const int ra = row0 + frl, ka = ra ^ (ra >> 3);
        const int kb = kk * 4 + fq;
        const bf16x8 a = *(const LAS bf16x8*)(A + ra * 128 + (((kb ^ ka) & 15) << 3));
#pragma unroll
        for (int n = 0; n < 8; ++n) {
            if (n < ntiles) {
                const int rb = n * 16 + frl;
                const bf16x8 b = *(const LAS bf16x8*)(B + rb * 128 + (((kb ^ rb ^ (rb >> 3)) & 15) << 3));
                acc[n] = __builtin_amdgcn_mfma_f32_16x16x32_bf16(b, a, acc[n], 0, 0, 0);
            }
        }
    }
}

struct EpiP {
    static constexpr bool PERM = true, AFTER_DRAIN = false;
    bf16_t* O;
    __device__ __forceinline__ void operator()(const f32x4 (&acc)[2][2][4][2], const pg8::Unit& u, int wr, int wc, int fr, int fq) const {
        const int row0 = u.pm * 256 + wr * 64 + fr, col0 = u.pn * 256 + wc * 32 + 8 * fq;
        const bool act = u.pn >= 8;
#pragma unroll
        for (int ai = 0; ai < 2; ++ai)
#pragma unroll
            for (int m = 0; m < 4; ++m) { bf16_t* rowp = O + (size_t)(row0 + ai * 128 + m * 16) * NP + col0;
#pragma unroll
                for (int bj = 0; bj < 2; ++bj) { f32x4 v0 = acc[ai][bj][m][0], v1 = acc[ai][bj][m][1];
                    if (act) { f32x2 a = pg8::gelu_pk((f32x2){v0[0], v0[1]}), b = pg8::gelu_pk((f32x2){v0[2], v0[3]}), c = pg8::gelu_pk((f32x2){v1[0], v1[1]}), d = pg8::gelu_pk((f32x2){v1[2], v1[3]});
                        v0 = (f32x4){a.x, a.y, b.x, b.y}; v1 = (f32x4){c.x, c.y, d.x, d.y}; }
                    u32x4 w; w.x = cvt_pk_bf16(v0[0], v0[1]); w.y = cvt_pk_bf16(v0[2], v0[3]); w.z = cvt_pk_bf16(v1[0], v1[1]); w.w = cvt_pk_bf16(v1[2], v1[3]);
                    *(u32x4*)(rowp + bj * 128) = w; } }
    }
};
struct EpiRes {
    static constexpr bool PERM = false, AFTER_DRAIN = false;
    float* C; const float* R;
    __device__ __forceinline__ void operator()(const f32x4 (&acc)[2][2][4][2], const pg8::Unit& u, int wr, int wc, int fr, int fq) const {
        const int row0 = u.pm * 256 + wr * 64 + fr, col0 = u.pn * 256 + wc * 32 + 4 * fq;
#pragma unroll
        for (int ai = 0; ai < 2; ++ai)
#pragma unroll
            for (int m = 0; m < 4; ++m) { const size_t off = (size_t)(row0 + ai * 128 + m * 16) * DM + col0;
#pragma unroll
                for (int bj = 0; bj < 2; ++bj)
#pragma unroll
                    for (int n = 0; n < 2; ++n) { const f32x4 r = *(const f32x4*)(R + off + bj * 128 + n * 16); *(f32x4*)(C + off + bj * 128 + n * 16) = acc[ai][bj][m][n] + ALPHA * r; } }
    }
};
struct EpiSwiglu {
    static constexpr bool PERM = true, AFTER_DRAIN = false;
    bf16_t* O;
    __device__ __forceinline__ void operator()(const f32x4 (&acc)[2][2][4][2], const pg8::Unit& u, int wr, int wc, int fr, int fq) const {
        const int row0 = u.pm * 256 + wr * 64 + fr, col0 = u.pn * 128 + wc * 32 + 8 * fq;
#pragma unroll
        for (int ai = 0; ai < 2; ++ai)
#pragma unroll
            for (int m = 0; m < 4; ++m) { bf16_t* rowp = O + (size_t)(row0 + ai * 128 + m * 16) * DFF + col0;
                float h[8];
#pragma unroll
                for (int n = 0; n < 2; ++n)
#pragma unroll
                    for (int j = 0; j < 4; ++j) h[n * 4 + j] = siluf(acc[ai][0][m][n][j]) * acc[ai][1][m][n][j];
                u32x4 w; w.x = cvt_pk_bf16(h[0], h[1]); w.y = cvt_pk_bf16(h[2], h[3]); w.z = cvt_pk_bf16(h[4], h[5]); w.w = cvt_pk_bf16(h[6], h[7]);
                *(u32x4*)rowp = w; }
    }
};

__device__ __forceinline__ void wt_tile(const Params& P, int t, const float*& src, int& lsrc, bf16_t*& dst, int& ldd) {
    unsigned char* ws = P.ws;
    if (t < 384) { const int kt = t / 24, nt = t % 24, n0 = nt * 128; src = P.in[1] + (size_t)kt * 64 * NIN + (n0 < 2048 ? n0 : n0 + 8); lsrc = NIN; dst = (bf16_t*)(ws + WS_WINT) + (size_t)n0 * 1024 + kt * 64; ldd = 1024; }
    else if (t < 512) { const int t2 = t - 384, kt = t2 >> 3, nt = t2 & 7; src = P.in[9] + (size_t)kt * 64 * 1024 + nt * 128; lsrc = 1024; dst = (bf16_t*)(ws + WS_WOUTT) + (size_t)nt * 128 * 1024 + kt * 64; ldd = 1024; }
    else if (t < 1216) { const int t2 = t - 512, kt = t2 / 44, nt = t2 % 44, pn = nt >> 1, bj = nt & 1; src = (bj ? P.in[13] : P.in[12]) + (size_t)kt * 64 * DFF + pn * 128; lsrc = DFF;
        dst = (bf16_t*)(ws + WS_WGUT) + (size_t)nt * 128 * 1024 + kt * 64; ldd = 1024; }
    else { const int t2 = t - 1216, kt = t2 >> 3, nt = t2 & 7; src = P.in[14] + (size_t)kt * 64 * 1024 + nt * 128; lsrc = 1024; dst = (bf16_t*)(ws + WS_WDOWNT) + (size_t)nt * 128 * DFF + kt * 64; ldd = DFF; }
}
__device__ __forceinline__ void phase_prep(const Params& P, LAS unsigned char* lds) {
    const int tid = threadIdx.x, lane = tid & 63, wid = __builtin_amdgcn_readfirstlane(tid >> 6);
    unsigned char* ws = P.ws;
    const int G = (int)gridDim.x;
    LAS float* tile = (LAS float*)lds;
    LAS float* wg = (LAS float*)(lds + 36864);
    for (int i = tid; i < 8192; i += 512) wg[i] = P.in[1][(size_t)(i >> 3) * NIN + 2048 + (i & 7)];
    {
        int t = blockIdx.x; f32x4 r[4]; const float* src; int lsrc; bf16_t* dst; int ldd;
        const int lr = tid >> 5, lc = (tid & 31) * 4;
        if (t < 1568) { wt_tile(P, t, src, lsrc, dst, ldd);
#pragma unroll
            for (int i = 0; i < 4; ++i) r[i] = *(const f32x4*)(src + (size_t)(i * 16 + lr) * lsrc + lc); }
        while (t < 1568) {
#pragma unroll
            for (int i = 0; i < 4; ++i) { LAS float* tp = tile + (i * 16 + lr) * 129 + lc; tp[0] = r[i][0]; tp[1] = r[i][1]; tp[2] = r[i][2]; tp[3] = r[i][3]; }
            bf16_t* cdst = dst; const int cldd = ldd;
            const int tn = t + G;
            if (tn < 1568) { wt_tile(P, tn, src, lsrc, dst, ldd);
#pragma unroll
                for (int i = 0; i < 4; ++i) r[i] = *(const f32x4*)(src + (size_t)(i * 16 + lr) * lsrc + lc); }
            __syncthreads();
            { const int n = tid >> 2, ks = (tid & 3) * 16; float v[16];
#pragma unroll
              for (int j = 0; j < 16; ++j) v[j] = tile[(ks + j) * 129 + n];
              u32x4 w0, w1; w0.x = cvt_pk_bf16(v[0], v[1]); w0.y = cvt_pk_bf16(v[2], v[3]); w0.z = cvt_pk_bf16(v[4], v[5]); w0.w = cvt_pk_bf16(v[6], v[7]);
              w1.x = cvt_pk_bf16(v[8], v[9]); w1.y = cvt_pk_bf16(v[10], v[11]); w1.z = cvt_pk_bf16(v[12], v[13]); w1.w = cvt_pk_bf16(v[14], v[15]);
              u32x4* o = (u32x4*)(cdst + (size_t)n * cldd + ks); o[0] = w0; o[1] = w1; }
            __syncthreads();
            t = tn;
        }
    }
    __syncthreads();
    bf16_t* xb = (bf16_t*)(ws + WS_XB); float* gates = (float*)(ws + WS_GATES);
    const float bg = P.in[2][lane & 7];
    int row = blockIdx.x * 8 + wid; f32x4 nv[4];
    if (row < T_TOK) {
#pragma unroll
        for (int i = 0; i < 4; ++i) nv[i] = ((const f32x4*)(P.in[0] + (size_t)row * DM))[i * 64 + lane]; }
    while (row < T_TOK) {
        f32x4 cv[4];
#pragma unroll
        for (int i = 0; i < 4; ++i) cv[i] = nv[i];
        const int rown = row + G * 8;
        if (rown < T_TOK) {
#pragma unroll
            for (int i = 0; i < 4; ++i) nv[i] = ((const f32x4*)(P.in[0] + (size_t)rown * DM))[i * 64 + lane]; }
        float a[8];
#pragma unroll
        for (int j = 0; j < 8; ++j) a[j] = 0.f;
#pragma unroll
        for (int i = 0; i < 4; ++i) { const f32x4 v = cv[i]; const int k = (i * 64 + lane) * 4;
            u32x2 w; w.x = cvt_pk_bf16(v[0], v[1]); w.y = cvt_pk_bf16(v[2], v[3]); *(u32x2*)(xb + (size_t)row * DM + k) = w;
#pragma unroll
            for (int e = 0; e < 4; ++e) { const f32x4 w0 = *(const LAS f32x4*)(wg + (k + e) * 8), w1 = *(const LAS f32x4*)(wg + (k + e) * 8 + 4);
                a[0] += v[e] * w0[0]; a[1] += v[e] * w0[1]; a[2] += v[e] * w0[2]; a[3] += v[e] * w0[3]; a[4] += v[e] * w1[0]; a[5] += v[e] * w1[1]; a[6] += v[e] * w1[2]; a[7] += v[e] * w1[3]; } }
#pragma unroll
        for (int j = 0; j < 8; ++j) {
#pragma unroll
            for (int o = 32; o >= 1; o >>= 1) a[j] += __shfl_xor(a[j], o); }
        float r = a[0]; r = (lane == 1) ? a[1] : r; r = (lane == 2) ? a[2] : r; r = (lane == 3) ? a[3] : r; r = (lane == 4) ? a[4] : r; r = (lane == 5) ? a[5] : r; r = (lane == 6) ? a[6] : r; r = (lane == 7) ? a[7] : r;
        if (lane < 8) gates[(size_t)row * 8 + lane] = r + bg;
        row = rown;
    }
    __syncthreads();
}

#define VT_WRITE8(Vt_, raw_, ch_, l_) do { \
    Vt_[swz((ch_) * 8 + 0, (l_))] = (bf16_t)((raw_).x & 0xffffu); Vt_[swz((ch_) * 8 + 1, (l_))] = (bf16_t)((raw_).x >> 16); \
    Vt_[swz((ch_) * 8 + 2, (l_))] = (bf16_t)((raw_).y & 0xffffu); Vt_[swz((ch_) * 8 + 3, (l_))] = (bf16_t)((raw_).y >> 16); \
    Vt_[swz((ch_) * 8 + 4, (l_))] = (bf16_t)((raw_).z & 0xffffu); Vt_[swz((ch_) * 8 + 5, (l_))] = (bf16_t)((raw_).z >> 16); \
    Vt_[swz((ch_) * 8 + 6, (l_))] = (bf16_t)((raw_).w & 0xffffu); Vt_[swz((ch_) * 8 + 7, (l_))] = (bf16_t)((raw_).w >> 16); } while (0)
__device__ __forceinline__ void conv_lds8(const LAS bf16_t* R, int l, int ch, const f32x4 (&w)[4][2], float (&y)[8]) {
#pragma unroll
    for (int i = 0; i < 8; ++i) y[i] = 0.f;
#pragma unroll
    for (int j = 0; j < 4; ++j) { const u32x4 raw = *(const LAS u32x4*)(R + (l + j) * 136 + ch * 8); float x[8]; unpack8(raw, x);
        y[0] += w[j][0][0] * x[0]; y[1] += w[j][0][1] * x[1]; y[2] += w[j][0][2] * x[2]; y[3] += w[j][0][3] * x[3]; y[4] += w[j][1][0] * x[4]; y[5] += w[j][1][1] * x[5]; y[6] += w[j][1][2] * x[6]; y[7] += w[j][1][3] * x[7]; }
#pragma unroll
    for (int i = 0; i < 8; ++i) y[i] = siluf(y[i]);
}
__device__ __forceinline__ void mlstm_local(const Params& P, LAS unsigned char* lds, int task) {
    int tid_ = threadIdx.x; asm volatile("" : "+v"(tid_));
    const int tid = tid_, lane = tid & 63, wid = __builtin_amdgcn_readfirstlane(tid >> 6), fr = lane & 15, fq = lane >> 4;
    const int bh = task >> 6, c = task & 63, b = bh >> 2, h = bh & 3, tok0 = b * SEQ + c * 128, pos0 = c * 128;
    unsigned char* ws = P.ws;
    LAS bf16_t* Vt = (LAS bf16_t*)lds; LAS bf16_t* Kt = (LAS bf16_t*)(lds + 32768); LAS bf16_t* RK = (LAS bf16_t*)(lds + 65536); LAS bf16_t* RQ = (LAS bf16_t*)(lds + 101376);
    LAS float* wsl = (LAS float*)(lds + 137216);
    const float* gates = (const float*)(ws + WS_GATES); const bf16_t* p = (const bf16_t*)(ws + WS_P);
    float gi0 = 0.f, gi1 = 0.f, gf0 = 0.f, gf1 = 0.f;
    if (wid == 0) { const int l0 = 2 * lane; gi0 = gates[(size_t)(tok0 + l0) * 8 + h]; gi1 = gates[(size_t)(tok0 + l0 + 1) * 8 + h]; gf0 = gates[(size_t)(tok0 + l0) * 8 + 4 + h]; gf1 = gates[(size_t)(tok0 + l0 + 1) * 8 + 4 + h]; }
    u32x4 rk[4], rq[4], rv[4], rke = (u32x4){0u, 0u, 0u, 0u}, rqe = (u32x4){0u, 0u, 0u, 0u};
#pragma unroll
    for (int j = 0; j < 4; ++j) { const int i = tid + 512 * j, r = i >> 4, cb = i & 15; const bool valid = pos0 - 3 + r >= 0;
        const bf16_t* src = p + (size_t)(tok0 - 3 + r) * NP + h * 128 + cb * 8;
        rk[j] = (u32x4){0u, 0u, 0u, 0u}; rq[j] = (u32x4){0u, 0u, 0u, 0u};
        if (valid) { rq[j] = *(const u32x4*)src; rk[j] = *(const u32x4*)(src + 512); } }
    if (tid < 48) { const int r = 128 + (tid >> 4), cb = tid & 15; const bf16_t* src = p + (size_t)(tok0 - 3 + r) * NP + h * 128 + cb * 8; rqe = *(const u32x4*)src; rke = *(const u32x4*)(src + 512); }
#pragma unroll
    for (int it = 0; it < 4; ++it) { const int l = it * 32 + wid * 4 + (lane & 3), ch = lane >> 2; rv[it] = *(const u32x4*)(p + (size_t)(tok0 + l) * NP + 1024 + h * 128 + ch * 8); }
    if (wid == 0) {
        const int l0 = 2 * lane;
        const float lf0 = logsigmoid(gf0), lf1 = logsigmoid(gf1);
        const float s1 = lf0 + lf1; float tot = s1;
#pragma unroll
        for (int o = 1; o < 64; o <<= 1) { const float t = __shfl_up(tot, o); if (lane >= o) tot += t; }
        const float ex = tot - s1, b0 = ex + lf0, b1 = ex + s1, g = __shfl(tot, 63);
        const float w0 = g - b0 + gi0, w1 = g - b1 + gi1; float mx = fmaxf(w0, w1);
#pragma unroll
        for (int o = 32; o >= 1; o >>= 1) mx = fmaxf(mx, __shfl_xor(mx, o));
        wsl[l0] = __expf(w0 - mx); wsl[l0 + 1] = __expf(w1 - mx);
        if (lane == 0) { ((float*)(ws + WS_SMALL + SM_GTOT))[task] = g; ((float*)(ws + WS_SMALL + SM_MLOC))[task] = mx; }
    }
#pragma unroll
    for (int j = 0; j < 4; ++j) { const int i = tid + 512 * j, r = i >> 4, cb = i & 15; *(LAS u32x4*)(RK + r * 136 + cb * 8) = rk[j]; *(LAS u32x4*)(RQ + r * 136 + cb * 8) = rq[j]; }
    if (tid < 48) { const int r = 128 + (tid >> 4), cb = tid & 15; *(LAS u32x4*)(RK + r * 136 + cb * 8) = rke; *(LAS u32x4*)(RQ + r * 136 + cb * 8) = rqe; }
#pragma unroll
    for (int it = 0; it < 4; ++it) { const int l = it * 32 + wid * 4 + (lane & 3), ch = lane >> 2; VT_WRITE8(Vt, rv[it], ch, l); }
    __syncthreads();
    {   const int ch = lane >> 2; f32x4 w[4][2];
        const float* cw = P.in[3] + 512 + h * 128 + ch * 8;
#pragma unroll
        for (int j = 0; j < 4; ++j) { w[j][0] = *(const f32x4*)(cw + j * 1024); w[j][1] = *(const f32x4*)(cw + j * 1024 + 4); }
        bf16_t* KC = (bf16_t*)(ws + WS_KC);
#pragma unroll
        for (int it = 0; it < 4; ++it) { const int l = it * 32 + wid * 4 + (lane & 3); float y[8]; conv_lds8(RK, l, ch, w, y);
            const float sc = 0.08838834764831845f, wl = wsl[l];
#pragma unroll
            for (int i = 0; i < 8; ++i) { y[i] *= sc; Kt[swz(ch * 8 + i, l)] = f2bf(y[i] * wl); }
            u32x4 o; o.x = cvt_pk_bf16(y[0], y[1]); o.y = cvt_pk_bf16(y[2], y[3]); o.z = cvt_pk_bf16(y[4], y[5]); o.w = cvt_pk_bf16(y[6], y[7]);
            *(u32x4*)(KC + (size_t)(tok0 + l) * 512 + h * 128 + ch * 8) = o; }
        cw = P.in[3] + h * 128 + ch * 8;
#pragma unroll
        for (int j = 0; j < 4; ++j) { w[j][0] = *(const f32x4*)(cw + j * 1024); w[j][1] = *(const f32x4*)(cw + j * 1024 + 4); }
        bf16_t* QC = (bf16_t*)(ws + WS_QC);
#pragma unroll
        for (int it = 0; it < 4; ++it) { const int l = it * 32 + wid * 4 + (lane & 3); float y[8]; conv_lds8(RQ, l, ch, w, y);
            u32x4 o; o.x = cvt_pk_bf16(y[0], y[1]); o.y = cvt_pk_bf16(y[2], y[3]); o.z = cvt_pk_bf16(y[4], y[5]); o.w = cvt_pk_bf16(y[6], y[7]);
            *(u32x4*)(QC + (size_t)(tok0 + l) * 512 + h * 128 + ch * 8) = o; }
    }
    __syncthreads();
    f32x4 acc[8];
#pragma unroll
    for (int n = 0; n < 8; ++n) acc[n] = (f32x4){0.f, 0.f, 0.f, 0.f};
    wave_mm(Vt, Kt, acc, wid * 16, fr, fq, 4, 8);
    float* dC = (float*)(ws + WS_DC) + (size_t)task * 16384 + (wid * 16 + fr) * 128 + fq * 4;
#pragma unroll
    for (int n = 0; n < 8; ++n) *(f32x4*)(dC + n * 16) = acc[n];
    if (tid < 128) { float s = 0.f;
#pragma unroll
        for (int blk = 0; blk < 16; ++blk) { const u32x4 r = *(const LAS u32x4*)(Kt + tid * 128 + blk * 8); float x[8]; unpack8(r, x); s += ((x[0] + x[1]) + (x[2] + x[3])) + ((x[4] + x[5]) + (x[6] + x[7])); }
        ((float*)(ws + WS_SMALL + SM_DN))[task * 128 + tid] = s; }
    __syncthreads();
}

__device__ __forceinline__ void sgu_task(const Params& P, LAS unsigned char* lds, int task) {
    int tid_ = threadIdx.x; asm volatile("" : "+v"(tid_));
    const int tid = tid_, lane = tid & 63, wid = __builtin_amdgcn_readfirstlane(tid >> 6), fr = lane & 15, fq = lane >> 4;
    const int b = task >> 8, c = (task >> 2) & 63, g = task & 3, tok0 = b * SEQ + c * 128;
    unsigned char* ws = P.ws;
    LAS bf16_t* Wl = (LAS bf16_t*)lds; LAS bf16_t* Vst = (LAS bf16_t*)(lds + 32768);
    const bf16_t* p = (const bf16_t*)(ws + WS_P);
    f32x4 wa[4], wb[4]; u32x4 rv[4]; u32x2 ur[8];
#pragma unroll
    for (int it = 0; it < 4; ++it) { const int i = it * 512 + tid, t = i >> 4, sb = i & 15; const float* src = P.in[7] + (size_t)g * 16384 + t * 128 + sb * 8; wa[it] = *(const f32x4*)src; wb[it] = *(const f32x4*)(src + 4); }
#pragma unroll
    for (int it = 0; it < 4; ++it) { const int l = it * 32 + wid * 4 + (lane & 3), ch = lane >> 2; rv[it] = *(const u32x4*)(p + (size_t)(tok0 + l) * NP + 2560 + g * 128 + ch * 8); }
    { const bf16_t* up = p + (size_t)(tok0 + wid * 16 + fr) * NP + 2048 + g * 128 + fq * 4;
#pragma unroll
      for (int n = 0; n < 8; ++n) ur[n] = *(const u32x2*)(up + n * 16); }
    const float bsp = P.in[8][g * 128 + wid * 16 + fr];
#pragma unroll
    for (int it = 0; it < 4; ++it) {
        const int i = it * 512 + tid, t = i >> 4, sb = i & 15, s0 = sb * 8;
        float v[8] = {wa[it][0], wa[it][1], wa[it][2], wa[it][3], wb[it][0], wb[it][1], wb[it][2], wb[it][3]};
#pragma unroll
        for (int e = 0; e < 8; ++e) v[e] = (s0 + e <= t) ? v[e] : 0.f;
        u32x4 w; w.x = cvt_pk_bf16(v[0], v[1]); w.y = cvt_pk_bf16(v[2], v[3]); w.z = cvt_pk_bf16(v[4], v[5]); w.w = cvt_pk_bf16(v[6], v[7]);
        *(LAS u32x4*)(Wl + swz(t, s0)) = w;
    }
    { const int ch = lane >> 2; const float* nwp = P.in[5] + g * 128 + ch * 8; const float* nbp = P.in[6] + g * 128 + ch * 8;
      const f32x4 nw0 = *(const f32x4*)nwp, nw1 = *(const f32x4*)(nwp + 4), nb0 = *(const f32x4*)nbp, nb1 = *(const f32x4*)(nbp + 4);
      const float nw[8] = {nw0[0], nw0[1], nw0[2], nw0[3], nw1[0], nw1[1], nw1[2], nw1[3]}; const float nb[8] = {nb0[0], nb0[1], nb0[2], nb0[3], nb1[0], nb1[1], nb1[2], nb1[3]};
#pragma unroll
      for (int it = 0; it < 4; ++it) {
        const int l = it * 32 + wid * 4 + (lane & 3);
        float x[8]; unpack8(rv[it], x);
        float s = ((x[0] + x[1]) + (x[2] + x[3])) + ((x[4] + x[5]) + (x[6] + x[7]));
        s += __shfl_xor(s, 4); s += __shfl_xor(s, 8); s += __shfl_xor(s, 16); s += __shfl_xor(s, 32);
        const float mu = s * (1.f / 128.f); float q = 0.f;
#pragma unroll
        for (int e = 0; e < 8; ++e) { x[e] -= mu; q += x[e] * x[e]; }
        q += __shfl_xor(q, 4); q += __shfl_xor(q, 8); q += __shfl_xor(q, 16); q += __shfl_xor(q, 32);
        const float rstd = rsqrtf(q * (1.f / 128.f) + LN_EPS);
#pragma unroll
        for (int e = 0; e < 8; ++e) Vst[swz(ch * 8 + e, l)] = f2bf(x[e] * rstd * nw[e] + nb[e]);
      } }
    __syncthreads();
    f32x4 acc[8];
#pragma unroll
    for (int n = 0; n < 8; ++n) acc[n] = (f32x4){0.f, 0.f, 0.f, 0.f};
    wave_mm(Wl, Vst, acc, wid * 16, fr, fq, (wid >> 1) + 1, 8);
    { const int t = wid * 16 + fr, tok = tok0 + t;
      bf16_t* yp = (bf16_t*)(ws + WS_Y) + (size_t)tok * DM + 512 + g * 128 + fq * 4;
#pragma unroll
      for (int n = 0; n < 8; ++n) {
          u32x2 w; w.x = cvt_pk_bf16(bflo(ur[n].x) * (acc[n][0] + bsp), bfhi(ur[n].x) * (acc[n][1] + bsp)); w.y = cvt_pk_bf16(bflo(ur[n].y) * (acc[n][2] + bsp), bfhi(ur[n].y) * (acc[n][3] + bsp));
          *(u32x2*)(yp + n * 16) = w; } }
    __syncthreads();
}

__device__ __forceinline__ void phase_scan(const Params& P) {
    unsigned char* ws = P.ws;
    const float* __restrict__ gt = (const float*)(ws + WS_SMALL + SM_GTOT); const float* __restrict__ ml = (const float*)(ws + WS_SMALL + SM_MLOC);
    const float* __restrict__ dC = (const float*)(ws + WS_DC); unsigned* __restrict__ Cp = (unsigned*)(ws + WS_CPREV);
    for (int idx = blockIdx.x * 512 + threadIdx.x; idx < 8 * 8192; idx += gridDim.x * 512) {
        const int bh = idx >> 13, e = (idx & 8191) * 2;
        float m = 0.f, c0 = 0.f, c1 = 0.f;
#pragma unroll 1
        for (int cb = 0; cb < 64; cb += 16) {
            f32x2 d[16]; float g[16], l[16];
#pragma unroll
            for (int i = 0; i < 16; ++i) { const int task = bh * 64 + cb + i; d[i] = *(const f32x2*)(dC + (size_t)task * 16384 + e); g[i] = gt[task]; l[i] = ml[task]; }
#pragma unroll
            for (int i = 0; i < 16; ++i) { const int task = bh * 64 + cb + i;
                Cp[((size_t)task * 16384 + e) >> 1] = cvt_pk_bf16(c0, c1);
                const float mn = fmaxf(g[i] + m, l[i]), dec = __expf(g[i] + m - mn), sc = __expf(l[i] - mn);
                c0 = dec * c0 + sc * d[i].x; c1 = dec * c1 + sc * d[i].y; m = mn; }
        }
    }
    const float* __restrict__ dn = (const float*)(ws + WS_SMALL + SM_DN); float* __restrict__ np = (float*)(ws + WS_SMALL + SM_NPREV); float* __restrict__ mp = (float*)(ws + WS_SMALL + SM_MPREV);
    for (int idx = blockIdx.x * 512 + threadIdx.x; idx < 8 * 128; idx += gridDim.x * 512) {
        const int bh = idx >> 7, k = idx & 127;
        float m = 0.f, n = 0.f;
#pragma unroll 1
        for (int cb = 0; cb < 64; cb += 16) {
            float d[16], g[16], l[16];
#pragma unroll
            for (int i = 0; i < 16; ++i) { const int task = bh * 64 + cb + i; d[i] = dn[task * 128 + k]; g[i] = gt[task]; l[i] = ml[task]; }
#pragma unroll
            for (int i = 0; i < 16; ++i) { const int task = bh * 64 + cb + i;
                np[task * 128 + k] = n; if (k == 0) mp[task] = m;
                const float mn = fmaxf(g[i] + m, l[i]), dec = __expf(g[i] + m - mn), sc = __expf(l[i] - mn);
                n = dec * n + sc * d[i]; m = mn; }
        }
    }
}

__device__ __forceinline__ void mlstm_out(const Params& P, LAS unsigned char* lds, int task) {
    int tid_ = threadIdx.x; asm volatile("" : "+v"(tid_));
    const int tid = tid_, lane = tid & 63, wid = __builtin_amdgcn_readfirstlane(tid >> 6), fr = lane & 15, fq = lane >> 4;
    const int bh = task >> 6, c = task & 63, b = bh >> 2, h = bh & 3, tok0 = b * SEQ + c * 128;
    unsigned char* ws = P.ws;
    LAS bf16_t* Ql = (LAS bf16_t*)lds; LAS bf16_t* Kl = (LAS bf16_t*)(lds + 32768); LAS bf16_t* Vt = (LAS bf16_t*)(lds + 65536); LAS bf16_t* Cl = (LAS bf16_t*)(lds + 98304);
    LAS float* ibl = (LAS float*)(lds + 131072); LAS float* mjl = ibl + 128; LAS float* al = ibl + 256; LAS float* rcl = ibl + 384; LAS float* nl = ibl + 512;
    const float* gates = (const float*)(ws + WS_GATES); const bf16_t* p = (const bf16_t*)(ws + WS_P);
    float gi0 = 0.f, gi1 = 0.f, gf0 = 0.f, gf1 = 0.f, mprev = 0.f, n0v = 0.f, n1v = 0.f;
    if (wid == 0) { const int l0 = 2 * lane; gi0 = gates[(size_t)(tok0 + l0) * 8 + h]; gi1 = gates[(size_t)(tok0 + l0 + 1) * 8 + h]; gf0 = gates[(size_t)(tok0 + l0) * 8 + 4 + h]; gf1 = gates[(size_t)(tok0 + l0 + 1) * 8 + 4 + h];
        mprev = ((const float*)(ws + WS_SMALL + SM_MPREV))[task]; }
    else if (wid == 1) { n0v = ((const float*)(ws + WS_SMALL + SM_NPREV))[task * 128 + lane]; n1v = ((const float*)(ws + WS_SMALL + SM_NPREV))[task * 128 + lane + 64]; }
    u32x4 rq[4], rk[4], rv[4], rcv[4];
#pragma unroll
    for (int it = 0; it < 4; ++it) { const int i = it * 512 + tid, l = i >> 4, cb = i & 15;
        rq[it] = *(const u32x4*)((const bf16_t*)(ws + WS_QC) + (size_t)(tok0 + l) * 512 + h * 128 + cb * 8);
        rk[it] = *(const u32x4*)((const bf16_t*)(ws + WS_KC) + (size_t)(tok0 + l) * 512 + h * 128 + cb * 8);
        rcv[it] = *(const u32x4*)((const bf16_t*)(ws + WS_CPREV) + (size_t)task * 16384 + l * 128 + cb * 8); }
#pragma unroll
    for (int it = 0; it < 4; ++it) { const int l = it * 32 + wid * 4 + (lane & 3), ch = lane >> 2; rv[it] = *(const u32x4*)(p + (size_t)(tok0 + l) * NP + 1024 + h * 128 + ch * 8); }
    if (wid == 0) {
        const int l0 = 2 * lane;
        const float lf0 = logsigmoid(gf0), lf1 = logsigmoid(gf1);
        const float s1 = lf0 + lf1; float tot = s1;
#pragma unroll
        for (int o = 1; o < 64; o <<= 1) { const float t = __shfl_up(tot, o); if (lane >= o) tot += t; }
        const float ex = tot - s1, b0 = ex + lf0, b1 = ex + s1;
        const float ib0 = gi0 - b0, ib1 = gi1 - b1; const float pl = fmaxf(ib0, ib1); float pm = pl;
#pragma unroll
        for (int o = 1; o < 64; o <<= 1) { const float t = __shfl_up(pm, o); if (lane >= o) pm = fmaxf(pm, t); }
        float pex = __shfl_up(pm, 1); if (lane == 0) pex = -INFINITY;
        const float pm0 = fmaxf(pex, ib0), pm1 = fmaxf(pex, pl);
        const float mj0 = b0 + fmaxf(mprev, pm0), mj1 = b1 + fmaxf(mprev, pm1);
        ibl[l0] = ib0; ibl[l0 + 1] = ib1; mjl[l0] = mj0; mjl[l0 + 1] = mj1;
        al[l0] = __expf(b0 + mprev - mj0); al[l0 + 1] = __expf(b1 + mprev - mj1); rcl[l0] = b0 - mj0; rcl[l0 + 1] = b1 - mj1;
    } else if (wid == 1) { nl[lane] = n0v; nl[lane + 64] = n1v; }
#pragma unroll
    for (int it = 0; it < 4; ++it) { const int i = it * 512 + tid, l = i >> 4, cb = i & 15;
        *(LAS u32x4*)(Ql + swz(l, cb * 8)) = rq[it]; *(LAS u32x4*)(Kl + swz(l, cb * 8)) = rk[it]; *(LAS u32x4*)(Cl + swz(l, cb * 8)) = rcv[it]; }
#pragma unroll
    for (int it = 0; it < 4; ++it) { const int l = it * 32 + wid * 4 + (lane & 3), ch = lane >> 2; VT_WRITE8(Vt, rv[it], ch, l); }
    __syncthreads();
    const int l = wid * 16 + fr;
    f32x4 acc[8];
#pragma unroll
    for (int n = 0; n < 8; ++n) acc[n] = (f32x4){0.f, 0.f, 0.f, 0.f};
    wave_mm(Ql, Kl, acc, wid * 16, fr, fq, 4, wid + 1);
    const float rc = rcl[l];
    float rs = 0.f;
#pragma unroll
    for (int n = 0; n < 8; ++n) {
#pragma unroll
        for (int j = 0; j < 4; ++j) { const int s = n * 16 + fq * 4 + j; const float w = (s <= l) ? __expf(rc + ibl[s]) : 0.f; const float v = acc[n][j] * w; acc[n][j] = v; rs += v; } }
    rs += __shfl_xor(rs, 16); rs += __shfl_xor(rs, 32);
    float nq = 0.f;
#pragma unroll
    for (int blk = 0; blk < 4; ++blk) { const int kb = fq * 4 + blk; const u32x4 r = *(const LAS u32x4*)(Ql + swz(l, kb * 8)); float x[8]; unpack8(r, x);
#pragma unroll
        for (int e = 0; e < 8; ++e) nq += x[e] * nl[kb * 8 + e]; }
    nq += __shfl_xor(nq, 16); nq += __shfl_xor(nq, 32);
    __syncthreads();
#pragma unroll
    for (int n = 0; n < 8; ++n) { u32x2 w; w.x = cvt_pk_bf16(acc[n][0], acc[n][1]); w.y = cvt_pk_bf16(acc[n][2], acc[n][3]); *(LAS u32x2*)(Kl + swz(l, n * 16 + fq * 4)) = w; }
    __syncthreads();
    const float a = al[l], mj = mjl[l];
#pragma unroll
    for (int n = 0; n < 8; ++n) acc[n] = (f32x4){0.f, 0.f, 0.f, 0.f};
    wave_mm(Ql, Cl, acc, wid * 16, fr, fq, 4, 8);
#pragma unroll
    for (int n = 0; n < 8; ++n) acc[n] *= a;
    wave_mm(Kl, Vt, acc, wid * 16, fr, fq, (wid >> 1) + 1, 8);
    const float den = rs + a * nq, hd = fmaxf(fabsf(den), __expf(-mj)), inv = 1.f / hd;
    float sum = 0.f;
#pragma unroll
    for (int n = 0; n < 8; ++n) { acc[n] *= inv; sum += (acc[n][0] + acc[n][1]) + (acc[n][2] + acc[n][3]); }
    sum += __shfl_xor(sum, 16); sum += __shfl_xor(sum, 32);
    const float mu = sum * (1.f / 128.f); float q = 0.f;
#pragma unroll
    for (int n = 0; n < 8; ++n) { acc[n] -= mu; q += (acc[n][0] * acc[n][0] + acc[n][1] * acc[n][1]) + (acc[n][2] * acc[n][2] + acc[n][3] * acc[n][3]); }
    q += __shfl_xor(q, 16); q += __shfl_xor(q, 32);
    const float rstd = rsqrtf(q * (1.f / 128.f) + LN_EPS);
    { const int tok = tok0 + l; const float* nw = P.in[4] + h * 128 + fq * 4; const bf16_t* ogp = p + (size_t)tok * NP + 1536 + h * 128 + fq * 4;
      bf16_t* yp = (bf16_t*)(ws + WS_Y) + (size_t)tok * DM + h * 128 + fq * 4;
#pragma unroll
      for (int n = 0; n < 8; ++n) { const u32x2 orw = *(const u32x2*)(ogp + n * 16); const f32x4 w4 = *(const f32x4*)(nw + n * 16);
          const float o0 = 1.f / (1.f + __expf(-bflo(orw.x))), o1 = 1.f / (1.f + __expf(-bfhi(orw.x))), o2 = 1.f / (1.f + __expf(-bflo(orw.y))), o3 = 1.f / (1.f + __expf(-bfhi(orw.y)));
          u32x2 w; w.x = cvt_pk_bf16(o0 * acc[n][0] * rstd * w4[0], o1 * acc[n][1] * rstd * w4[1]); w.y = cvt_pk_bf16(o2 * acc[n][2] * rstd * w4[2], o3 * acc[n][3] * rstd * w4[3]);
          *(u32x2*)(yp + n * 16) = w; } }
    __syncthreads();
}

__device__ __forceinline__ void phase_ln(const float* in, float* outf, bf16_t* outb, const float* w, const float* bsrc) {
    const int lane = threadIdx.x & 63, wid = threadIdx.x >> 6;
    f32x4 wv[4], bv[4];
#pragma unroll
    for (int i = 0; i < 4; ++i) { wv[i] = *(const f32x4*)(w + (i * 64 + lane) * 4); bv[i] = *(const f32x4*)(bsrc + (i * 64 + lane) * 4); }
    for (int row = blockIdx.x * 8 + wid; row < T_TOK; row += gridDim.x * 8) {
        const f32x4* xr = (const f32x4*)(in + (size_t)row * DM); f32x4 v[4]; float s = 0.f;
#pragma unroll
        for (int i = 0; i < 4; ++i) { v[i] = xr[i * 64 + lane]; s += (v[i][0] + v[i][1]) + (v[i][2] + v[i][3]); }
#pragma unroll
        for (int o = 32; o >= 1; o >>= 1) s += __shfl_xor(s, o);
        const float mu = s * (1.f / 1024.f); float q = 0.f;
#pragma unroll
        for (int i = 0; i < 4; ++i) { v[i] -= mu; q += (v[i][0] * v[i][0] + v[i][1] * v[i][1]) + (v[i][2] * v[i][2] + v[i][3] * v[i][3]); }
#pragma unroll
        for (int o = 32; o >= 1; o >>= 1) q += __shfl_xor(q, o);
        const float rstd = rsqrtf(q * (1.f / 1024.f) + LN_EPS);
#pragma unroll
        for (int i = 0; i < 4; ++i) { const f32x4 y = v[i] * rstd * wv[i] + bv[i];
            *(f32x4*)(outf + (size_t)row * DM + (i * 64 + lane) * 4) = y;
            if (outb) { u32x2 pk; pk.x = cvt_pk_bf16(y[0], y[1]); pk.y = cvt_pk_bf16(y[2], y[3]); *(u32x2*)(outb + (size_t)row * DM + (i * 64 + lane) * 4) = pk; } }
    }
}

#ifndef REP_PREP
#define REP_PREP 1
#endif
#ifndef REP_P2
#define REP_P2 1
#endif
#ifndef REP_P3
#define REP_P3 1
#endif
#ifndef REP_P4
#define REP_P4 1
#endif
__global__ void __launch_bounds__(512, 2) fwd_megakernel(Params P) {
    extern __shared__ __attribute__((aligned(16))) unsigned char shm[];
    LAS unsigned char* lds = (LAS unsigned char*)shm;
    cg::grid_group grid = cg::this_grid();
    unsigned char* ws = P.ws;
    const int G = (int)gridDim.x, bx = (int)blockIdx.x;
    volatile LAS unsigned* xst = (volatile LAS unsigned*)(lds + LDS_BYTES - 16);
    if (threadIdx.x < 4) xst[threadIdx.x] = 0u;
    __syncthreads();
    const bool use_cg = G > 1024;
    XcdBarrier xbar = xcd_barrier_post((unsigned*)(ws + WS_BAR), xst);
#define GRID_SEAM() do { if (use_cg) grid.sync(); else xcd_barrier(xbar); } while (0)

    for (int rep = 0; rep < REP_PREP; ++rep) { phase_prep(P, lds); GRID_SEAM(); }
    { pg8::Gemm g{(const bf16_t*)(ws + WS_XB), (const bf16_t*)(ws + WS_WINT), T_TOK, NP, DM}; pg8::StaticOrder S; S.init(T_TOK, NP, G, bx); EpiP E{(bf16_t*)(ws + WS_P)};
      pg8::gemm_phase<EpiP, pg8::StaticOrder, false>(lds, g, S, E, nullptr); }
    GRID_SEAM();
    for (int rep = 0; rep < REP_P2; ++rep) { for (int task = bx; task < 1024; task += G) { if (task < 512) mlstm_local(P, lds, task); else sgu_task(P, lds, task - 512); }
    GRID_SEAM(); }
    for (int rep = 0; rep < REP_P3; ++rep) { phase_scan(P); GRID_SEAM(); }
    for (int rep = 0; rep < REP_P4; ++rep) { for (int task = bx; task < 512; task += G) mlstm_out(P, lds, task);
    GRID_SEAM(); }
    { pg8::Gemm g{(const bf16_t*)(ws + WS_Y), (const bf16_t*)(ws + WS_WOUTT), T_TOK, DM, DM}; pg8::StaticOrder S; S.init(T_TOK, DM, G, bx); EpiRes E{(float*)(ws + WS_R1), P.in[0]};
      pg8::gemm_phase<EpiRes, pg8::StaticOrder, false>(lds, g, S, E, nullptr); }
    GRID_SEAM();
    phase_ln((const float*)(ws + WS_R1), (float*)(ws + WS_R1), (bf16_t*)(ws + WS_H1B), P.in[10], P.in[11]);
    GRID_SEAM();
    { pg8::Gemm g{(const bf16_t*)(ws + WS_H1B), (const bf16_t*)(ws + WS_WGUT), T_TOK, 2 * DFF, DM}; pg8::StaticOrder S; S.init(T_TOK, 2 * DFF, G, bx); EpiSwiglu E{(bf16_t*)(ws + WS_HDN)};
      pg8::gemm_phase<EpiSwiglu, pg8::StaticOrder, false>(lds, g, S, E, nullptr); }
    GRID_SEAM();
    { pg8::Gemm g{(const bf16_t*)(ws + WS_HDN), (const bf16_t*)(ws + WS_WDOWNT), T_TOK, DM, DFF}; pg8::StaticOrder S; S.init(T_TOK, DM, G, bx); EpiRes E{P.out, (const float*)(ws + WS_R1)};
      pg8::gemm_phase<EpiRes, pg8::StaticOrder, false>(lds, g, S, E, nullptr); }
    GRID_SEAM();
    phase_ln(P.out, P.out, nullptr, P.in[15], P.in[16]);
#ifdef REP_SYNC
    for (int rep = 0; rep < REP_SYNC; ++rep) GRID_SEAM();
#endif
}

extern "C" void kernel_launch(void* const* d_in, const int* in_sizes, int n_in, void* d_out, int out_size, void* d_ws, size_t ws_size, hipStream_t stream) {
    (void)in_sizes; (void)n_in; (void)out_size; (void)ws_size;
    static int grid_blocks = 0;
    if (!grid_blocks) {
        int dev = 0, cus = 0, per_cu = 0;
        hipGetDevice(&dev);
        hipDeviceGetAttribute(&cus, hipDeviceAttributeMultiprocessorCount, dev);
        if (hipFuncSetAttribute((const void*)fwd_megakernel, hipFuncAttributeMaxDynamicSharedMemorySize, LDS_BYTES) != hipSuccess) fprintf(stderr, "hipFuncSetAttribute failed\n");
        if (hipOccupancyMaxActiveBlocksPerMultiprocessor(&per_cu, (const void*)fwd_megakernel, 512, LDS_BYTES) != hipSuccess || per_cu < 1) { fprintf(stderr, "occupancy query failed\n"); per_cu = 1; }
        if (per_cu > 1) per_cu = 1;
        grid_blocks = cus * per_cu;
    }
    Params P{};
    for (int i = 0; i < 17; ++i) P.in[i] = (const float*)d_in[i];
    P.out = (float*)d_out; P.ws = (unsigned char*)d_ws;
    hipMemsetAsync((unsigned char*)d_ws + WS_BAR, 0, XCD_BAR_WORDS * sizeof(unsigned), stream);
    void* args[] = {&P};
    hipError_t e = hipLaunchCooperativeKernel((const void*)fwd_megakernel, dim3(grid_blocks), dim3(512), args, LDS_BYTES, stream);
    if (e != hipSuccess) fprintf(stderr, "cooperative launch failed: %s (grid %d)\n", hipGetErrorString(e), grid_blocks);
}
```

```cpp
#include <hip/hip_runtime.h>
#include <hip/hip_cooperative_groups.h>
#include <cstdio>
#include <cstddef>
namespace cg = cooperative_groups;
namespace pg8 {
#define PG8_LAS __attribute__((address_space(3)))
typedef unsigned short bf16_t;
typedef short bf16x8 __attribute__((ext_vector_type(8)));
typedef float f32x4 __attribute__((ext_vector_type(4)));
typedef unsigned u32x4 __attribute__((ext_vector_type(4)));
constexpr int BM = 256, BK = 64, HALF = 128, HTB = HALF * BK * 2  , STAGE_BYTES = 8 * HTB, NXCD = 8, WGM = 8;

__host__ __device__ __forceinline__ int lds_byte(int r, int c) { const int st = (r >> 4) * 2 + (c >> 5), rr = r & 15, cc = c & 31, ob = rr * 64 + cc * 2; return st * 1024 + (ob ^ (((ob >> 9) & 1) << 5)); }
__host__ __device__ __forceinline__ void stage_rc(int b, int& R, int& C) { const int st = b / 1024, sb = b % 1024, swz = sb ^ (((sb >> 9) & 1) << 5); R = (st >> 1) * 16 + swz / 64; C = (st & 1) * 32 + (swz % 64) / 2; }
__host__ __device__ __forceinline__ int perm32(int rho) { const int n = rho >> 4, i = rho & 15; return 8 * (i >> 2) + 4 * n + (i & 3); }

struct Unit { int pm, pn; };
struct Gemm { const bf16_t* A; const bf16_t* Bt; int M, N, K; };

struct StaticOrder {
    int nM, nN, nwg, G, c;
    __host__ __device__ void init(int M, int N, int G_, int c_) { nM = M / BM; nN = N / BM; nwg = nM * nN; G = G_; c = c_; }
    __host__ __device__ bool next(int i, Unit& u) const {
        const long L = (long)i * G + c; if (L >= nwg) return false;
        int wgid = (int)L; { const int q = nwg / NXCD, r = nwg % NXCD, xcd = wgid % NXCD, off = wgid / NXCD; wgid = (xcd < r ? xcd * (q + 1) : r * (q + 1) + (xcd - r) * q) + off; }
        const int nig = WGM * nN, gid = wgid / nig, fm = gid * WGM, gsz = (nM - fm) < WGM ? (nM - fm) : WGM;
        u.pm = fm + ((wgid % nig) % gsz); u.pn = (wgid % nig) / gsz; return true;
    }
    __device__ __forceinline__ void a_ready(const Unit&) const {}
    __device__ __forceinline__ void done(const Unit&) const {}
};
struct CountedOrder : StaticOrder {
    const unsigned* ready; unsigned need; unsigned* tmo;
    __device__ __forceinline__ void a_ready(const Unit& u) const {
        if (threadIdx.x < 64) {
            const unsigned long long t0 = __builtin_amdgcn_s_memrealtime(); unsigned polls = 0;
            while ((unsigned)__builtin_amdgcn_readfirstlane(__hip_atomic_load(ready + 64 * u.pm, __ATOMIC_RELAXED, __HIP_MEMORY_SCOPE_AGENT)) < need) {
                if ((++polls & 255u) == 0u && __builtin_amdgcn_readfirstlane(__hip_atomic_load(tmo, __ATOMIC_RELAXED, __HIP_MEMORY_SCOPE_AGENT)) != 0u) break;
                if (__builtin_amdgcn_s_memrealtime() - t0 > 2000000ull) {
                    if (threadIdx.x == 0) { unsigned expect = 0u; __hip_atomic_compare_exchange_strong(tmo + 1, &expect, 0x600u | (unsigned)(u.pm & 0xff), __ATOMIC_RELAXED, __ATOMIC_RELAXED, __HIP_MEMORY_SCOPE_AGENT); __hip_atomic_store(tmo, 1u, __ATOMIC_RELAXED, __HIP_MEMORY_SCOPE_AGENT); }
                    break; }
                __builtin_amdgcn_s_sleep(2); }
            __builtin_amdgcn_fence(__ATOMIC_ACQUIRE, "agent");
            asm volatile("s_waitcnt vmcnt(0)" ::: "memory");
        }
#if !defined(BROKEN_HOOK_NO_BARRIER)
        asm volatile("" ::: "memory"); __builtin_amdgcn_s_barrier(); asm volatile("" ::: "memory");
#endif
    }
};

__device__ __forceinline__ unsigned cvt_pk_bf16(float lo, float hi) { unsigned r; asm volatile("v_cvt_pk_bf16_f32 %0, %1, %2" : "=v"(r) : "v"(lo), "v"(hi)); return r; }
typedef float f32x2 __attribute__((ext_vector_type(2)));
__device__ __forceinline__ f32x2 gelu_pk(f32x2 v) {
    const f32x2 av = __builtin_elementwise_abs(v), d = av * 0.2316418882f + 1.0f;
    f32x2 t; t.x = __builtin_amdgcn_rcpf(d.x); t.y = __builtin_amdgcn_rcpf(d.y);
    f32x2 q = t * 0.5307027145f + (-0.7265760135f); q = q * t + 0.7107068705f; q = q * t + (-0.142248368f); q = q * t + 0.127414796f; q = q * t;
    const f32x2 s = (v * v) * (-0.72134752044f);
    f32x2 e; e.x = __builtin_amdgcn_exp2f(s.x); e.y = __builtin_amdgcn_exp2f(s.y);
    const f32x2 m = v * (q * e), r = v - m;
    f32x2 o; o.x = v.x < 0.f ? m.x : r.x; o.y = v.y < 0.f ? m.y : r.y; return o;
}

template <class Epi, class Sched, bool STAMP = false>
__device__ __forceinline__ void gemm_phase(PG8_LAS unsigned char* lds, const Gemm g, const Sched& S, const Epi& E, unsigned long long* stamps) {
    const int tid = threadIdx.x, wid = __builtin_amdgcn_readfirstlane(tid >> 6), lane = tid & 63, wr = wid >> 2, wc = wid & 3, fr = lane & 15, fq = lane >> 4;
    const int K = g.K, nt = K / BK;
    int ts_lo = 0, ts_hi = 0, nts = 0; const unsigned long long rt_entry = STAMP ? (unsigned long long)wall_clock64() : 0ull;
#define PG8_STAMP() do { if (STAMP && wid == 0 && nts < 64) { const unsigned long long _c = (unsigned long long)clock64(); \
        ts_lo = (lane == nts) ? (int)(unsigned)_c : ts_lo; ts_hi = (lane == nts) ? (int)(unsigned)(_c >> 32) : ts_hi; ++nts; } } while (0)
    PG8_STAMP();
    unsigned voffA[2], voffB[2];
#pragma unroll
    for (int i = 0; i < 2; ++i) { int R, C; stage_rc(tid * 16 + i * 8192, R, C); const int Rb = Epi::PERM ? ((R & ~31) + perm32(R & 31)) : R;
        voffA[i] = (unsigned)(R * K + C) * 2u; voffB[i] = (unsigned)(Rb * K + C) * 2u; }
    const size_t kstep = (size_t)(BK * 2);
    const size_t hstep = (size_t)HALF * K * 2;
    const size_t tstep = 2 * hstep;
    const unsigned ldsw = (unsigned)wid * 1024u;
    const int aoff = lds_byte(wr * 64 + fr, fq * 8), boff = lds_byte(wc * 32 + fr, fq * 8);
#define PG8_SA(b, h) (((b) * 2 + (h)) * HTB)
#define PG8_SB(b, h) ((4 + (b) * 2 + (h)) * HTB)
#define PG8_STAGE(bufoff, gbase, voff) do { _Pragma("unroll") for (int _i = 0; _i < 2; ++_i) \
        __builtin_amdgcn_global_load_lds((const unsigned*)((const char*)(gbase) + (voff)[_i]), (PG8_LAS unsigned*)(lds + (bufoff) + ldsw + _i * 8192), 16, 0, 0); } while (0)
#define PG8_LDA(dst, b, h) do { _Pragma("unroll") for (int m = 0; m < 4; ++m) _Pragma("unroll") for (int k = 0; k < 2; ++k) dst[m][k] = *(const PG8_LAS bf16x8*)(lds + PG8_SA(b, h) + aoff + m * 2048 + k * 1024); } while (0)
#define PG8_LDB(dst, b, h) do { _Pragma("unroll") for (int n = 0; n < 2; ++n) _Pragma("unroll") for (int k = 0; k < 2; ++k) dst[n][k] = *(const PG8_LAS bf16x8*)(lds + PG8_SB(b, h) + boff + n * 2048 + k * 1024); } while (0)
#define PG8_MMA(ai, bj, At, Bt) do { __builtin_amdgcn_s_setprio(1); _Pragma("unroll") for (int m = 0; m < 4; ++m) _Pragma("unroll") for (int n = 0; n < 2; ++n) _Pragma("unroll") for (int k = 0; k < 2; ++k) \
        acc[ai][bj][m][n] = __builtin_amdgcn_mfma_f32_16x16x32_bf16(Bt[n][k], At[m][k], acc[ai][bj][m][n], 0, 0, 0); __builtin_amdgcn_s_setprio(0); } while (0)
#define PG8_WAIT_V(n) asm volatile("s_waitcnt vmcnt(" #n ")" ::: "memory")
#define PG8_WAIT_L(n) asm volatile("s_waitcnt lgkmcnt(" #n ")" ::: "memory")
#define PG8_BAR __builtin_amdgcn_s_barrier()
#define PG8_SCHED __builtin_amdgcn_sched_barrier(0)
    Unit cur, nxt; int ui = 0;
    if (!S.next(0, cur)) return;
    f32x4 acc[2][2][4][2];
#pragma unroll
    for (int a = 0; a < 2; ++a)
#pragma unroll
        for (int b = 0; b < 2; ++b)
#pragma unroll
            for (int m = 0; m < 4; ++m)
#pragma unroll
                for (int n = 0; n < 2; ++n) acc[a][b][m][n] = (f32x4){0.f, 0.f, 0.f, 0.f};
    bf16x8 At[4][2], B0[2][2], B1[2][2];
    const char* cA = (const char*)g.A + (size_t)cur.pm * tstep; const char* cB = (const char*)g.Bt + (size_t)cur.pn * tstep;
    S.a_ready(cur);
    PG8_STAGE(PG8_SB(0, 0), cB, voffB); PG8_STAGE(PG8_SA(0, 0), cA, voffA); PG8_STAGE(PG8_SB(0, 1), cB + hstep, voffB); PG8_STAGE(PG8_SA(0, 1), cA + hstep, voffA);
    if (wr == 1) PG8_BAR;
    PG8_WAIT_V(4); PG8_BAR;
    PG8_STAGE(PG8_SB(1, 0), cB + kstep, voffB); PG8_STAGE(PG8_SA(1, 0), cA + kstep, voffA); PG8_STAGE(PG8_SB(1, 1), cB + hstep + kstep, voffB);
    PG8_WAIT_V(6); PG8_BAR;
    PG8_STAMP();
    for (;;) {
        const bool has_next = S.next(ui + 1, nxt);
        const char* nA = has_next ? (const char*)g.A + (size_t)nxt.pm * tstep : cA; const char* nB = has_next ? (const char*)g.Bt + (size_t)nxt.pn * tstep : cB;
        for (int t = 0; t < nt; t += 2) {
            const bool last = (t == nt - 2);
            const char* a1 = cA + (size_t)(t + 1) * kstep;
            const char* a2 = last ? nA : cA + (size_t)(t + 2) * kstep; const char* b2 = last ? nB : cB + (size_t)(t + 2) * kstep;
            const char* a3 = a2 + kstep; const char* b3 = b2 + kstep;
            if (last && has_next) S.a_ready(nxt);
            PG8_LDB(B0, 0, 0); PG8_SCHED; PG8_LDA(At, 0, 0); PG8_STAGE(PG8_SA(1, 1), a1 + hstep, voffA);
            PG8_WAIT_L(8); PG8_BAR; PG8_WAIT_L(0); PG8_MMA(0, 0, At, B0); PG8_BAR; PG8_SCHED;
            PG8_LDB(B1, 0, 1); PG8_STAGE(PG8_SB(0, 0), b2, voffB);
            PG8_BAR; PG8_WAIT_L(0); PG8_MMA(0, 1, At, B1); PG8_BAR;
            PG8_LDA(At, 0, 1); PG8_STAGE(PG8_SA(0, 0), a2, voffA);
            PG8_BAR; PG8_WAIT_L(0); PG8_MMA(1, 0, At, B0); PG8_BAR; PG8_SCHED;
            PG8_STAGE(PG8_SB(0, 1), b2 + hstep, voffB);
            PG8_WAIT_V(6); PG8_BAR; PG8_MMA(1, 1, At, B1); PG8_BAR;
            PG8_LDB(B0, 1, 0); PG8_SCHED; PG8_LDA(At, 1, 0); PG8_STAGE(PG8_SA(0, 1), a2 + hstep, voffA);
            PG8_WAIT_L(8); PG8_BAR; PG8_WAIT_L(0); PG8_MMA(0, 0, At, B0); PG8_BAR; PG8_SCHED;
            PG8_LDB(B1, 1, 1); PG8_STAGE(PG8_SB(1, 0), b3, voffB);
            PG8_BAR; PG8_WAIT_L(0); PG8_MMA(0, 1, At, B1); PG8_BAR;
            PG8_LDA(At, 1, 1); PG8_STAGE(PG8_SA(1, 0), a3, voffA);
            PG8_BAR; PG8_WAIT_L(0); PG8_MMA(1, 0, At, B0); PG8_BAR; PG8_SCHED;
            PG8_STAGE(PG8_SB(1, 1), b3 + hstep, voffB);
            PG8_WAIT_V(6); PG8_BAR; PG8_MMA(1, 1, At, B1); PG8_BAR;
        }
        PG8_STAMP();
        if constexpr (!Epi::AFTER_DRAIN) { E(acc, cur, wr, wc, fr, fq); S.done(cur); }
        PG8_STAMP();
        if (!has_next) break;
#pragma unroll
        for (int a = 0; a < 2; ++a)
#pragma unroll
            for (int b = 0; b < 2; ++b)
#pragma unroll
                for (int m = 0; m < 4; ++m)
#pragma unroll
                    for (int n = 0; n < 2; ++n) acc[a][b][m][n] = (f32x4){0.f, 0.f, 0.f, 0.f};
        cur = nxt; cA = nA; cB = nB; ++ui;
    }
    PG8_WAIT_V(0);
    if (wr == 0) PG8_BAR;
    PG8_BAR;
    if constexpr (Epi::AFTER_DRAIN) { E.fused(acc, cur, wr, wc, fr, fq, lds, wid, lane); S.done(cur); }
    PG8_STAMP();
    if (STAMP && wid == 0) { stamps[lane] = lane < nts ? (((unsigned long long)(unsigned)ts_hi << 32) | (unsigned)ts_lo) : 0ull;
        if (lane == 62) stamps[62] = rt_entry; if (lane == 63) stamps[63] = (unsigned long long)wall_clock64(); }
#undef PG8_STAMP
#undef PG8_SA
#undef PG8_SB
#undef PG8_STAGE
#undef PG8_LDA
#undef PG8_LDB
#undef PG8_MMA
#undef PG8_WAIT_V
#undef PG8_WAIT_L
#undef PG8_BAR
#undef PG8_SCHED
}
}
#define XB_TMO      128
#define XB_XCNT(j)  (256  + 64 * (j))
#define XB_XSUB(j)  (1280 + 64 * (j))
#define XB_XGEN(j)  (2304 + 64 * (j))
#define XB_TOP      3328
#define XB_TOPGEN   3392
#define XCD_BAR_WORDS 3456
#define XB_SPIN_CAP (1u << 18)
#ifndef LAS
#define LAS __attribute__((address_space(3)))
#endif

__device__ __forceinline__ unsigned xb_ld(unsigned* p)              { return __hip_atomic_load(p, __ATOMIC_RELAXED, __HIP_MEMORY_SCOPE_AGENT); }
__device__ __forceinline__ unsigned xb_add(unsigned* p, unsigned v) { return __hip_atomic_fetch_add(p, v, __ATOMIC_RELAXED, __HIP_MEMORY_SCOPE_AGENT); }
__device__ __forceinline__ unsigned xb_xcc_id() { return (unsigned)__builtin_amdgcn_s_getreg((3 << 11) | 20) & 0xFu; }
#define XB_SPIN(cond, bar) do { unsigned _sp = 0; while (cond) { __builtin_amdgcn_s_sleep(1); \
    if ((++_sp & 255u) == 0u) { if (xb_ld(&(bar)[XB_TMO])) break; if (_sp > XB_SPIN_CAP) { atomicAdd(&(bar)[XB_TMO], 1u); break; } } } } while (0)

struct XcdBarrier {
    unsigned* bar; unsigned x;
    volatile LAS unsigned* st;
};

__device__ __forceinline__ XcdBarrier xcd_barrier_post(unsigned* bar, volatile LAS unsigned* st) {
    XcdBarrier b; b.bar = bar; b.x = xb_xcc_id(); b.st = st;
    if (threadIdx.x == 0) (void)xb_add(&bar[XB_XCNT(b.x)], 1u);
    return b;
}
__device__ __forceinline__ void xcd_barrier_complete(unsigned* bar, unsigned x, unsigned& nloc, unsigned& nx) {
    const unsigned G = gridDim.x * gridDim.y * gridDim.z;
    unsigned sum, cnt, mine, sp = 0u;
    for (;;) {
        sum = 0u; cnt = 0u; mine = 0u;
#pragma unroll
        for (unsigned j = 0; j < 16; ++j) { const unsigned c = xb_ld(&bar[XB_XCNT(j)]); sum += c; cnt += (c > 0u) ? 1u : 0u; mine = (j == x) ? c : mine; }
        if (sum == G) break;
        __builtin_amdgcn_s_sleep(1);
        if ((++sp & 255u) == 0u) { if (xb_ld(&bar[XB_TMO])) break; if (sp > XB_SPIN_CAP) { atomicAdd(&bar[XB_TMO], 1u); break; } }
    }
    nloc = mine > 0u ? mine : 1u; nx = cnt > 0u ? cnt : 1u;
}

__device__ __forceinline__ void xcd_barrier(const XcdBarrier& b) {
    asm volatile("s_waitcnt vmcnt(0)" ::: "memory");
    __syncthreads();
    if (threadIdx.x == 0) {
        unsigned* bar = b.bar;
        __builtin_amdgcn_s_waitcnt(0);
        unsigned nloc = b.st[0], nx = b.st[1];
        if (nloc == 0u) { xcd_barrier_complete(bar, b.x, nloc, nx); b.st[0] = nloc; b.st[1] = nx; }
        const unsigned old = xb_add(&bar[XB_XSUB(b.x)], 1u);
        const unsigned gen = old / nloc;
        if (old + 1u == (gen + 1u) * nloc) {
            __builtin_amdgcn_fence(__ATOMIC_RELEASE, "agent");
            asm volatile("s_waitcnt vmcnt(0)" ::: "memory");
            const unsigned og = xb_add(&bar[XB_TOP], 1u);
            const unsigned tg = og / nx;
            if (og + 1u == (tg + 1u) * nx) xb_add(&bar[XB_TOPGEN], 1u);
            else XB_SPIN(xb_ld(&bar[XB_TOPGEN]) == tg, bar);
            __builtin_amdgcn_fence(__ATOMIC_ACQUIRE, "agent");
            xb_add(&bar[XB_XGEN(b.x)], 1u);
            asm volatile("s_waitcnt vmcnt(0)" ::: "memory");
        } else {
            XB_SPIN(xb_ld(&bar[XB_XGEN(b.x)]) == gen, bar);
            __builtin_amdgcn_fence(__ATOMIC_ACQUIRE, "agent");
            asm volatile("s_waitcnt vmcnt(0)" ::: "memory");
        }
    }
    __syncthreads();
}


using pg8::bf16_t; using pg8::bf16x8; using pg8::f32x4; using pg8::u32x4; using pg8::f32x2; using pg8::cvt_pk_bf16;
#define LAS __attribute__((address_space(3)))
typedef unsigned u32x2 __attribute__((ext_vector_type(2)));

constexpr int T_TOK = 16384, DM = 1024, SEQ = 8192, NP = 3072, DFF = 2816, NIN = 3080;
constexpr float ALPHA = 1.189207115002721f;
constexpr float LN_EPS = 1e-5f;
constexpr size_t MiB = (size_t)1 << 20;
constexpr size_t WS_WINT = 0, WS_WOUTT = 6 * MiB, WS_WGUT = 8 * MiB, WS_WDOWNT = 19 * MiB, WS_GATES = 24 * MiB + 512 * 1024, WS_SMALL = 25 * MiB,
                 WS_P = 26 * MiB, WS_XB = 122 * MiB, WS_DC = 122 * MiB, WS_CPREV = 154 * MiB, WS_Y = 170 * MiB, WS_R1 = 26 * MiB, WS_H1B = 90 * MiB, WS_HDN = 122 * MiB, WS_QC = 202 * MiB, WS_KC = 218 * MiB;
constexpr size_t SM_DN = 0, SM_NPREV = 256 * 1024, SM_MLOC = 512 * 1024, SM_GTOT = 512 * 1024 + 2048, SM_MPREV = 512 * 1024 + 4096, SM_STATS = 800 * 1024;
constexpr int LDS_BYTES = 136 * 1024;
constexpr size_t WS_BAR = 25 * MiB + 768 * 1024;

struct Params { const float* in[17]; float* out; unsigned char* ws; };

__device__ __forceinline__ float bflo(unsigned w) { return __uint_as_float(w << 16); }
__device__ __forceinline__ float bfhi(unsigned w) { return __uint_as_float(w & 0xffff0000u); }
__device__ __forceinline__ unsigned short f2bf(float f) { unsigned u = __float_as_uint(f); u += 0x7fffu + ((u >> 16) & 1u); return (unsigned short)(u >> 16); }
__device__ __forceinline__ void unpack8(const u32x4 r, float (&x)[8]) {
    x[0] = bflo(r.x); x[1] = bfhi(r.x); x[2] = bflo(r.y); x[3] = bfhi(r.y); x[4] = bflo(r.z); x[5] = bfhi(r.z); x[6] = bflo(r.w); x[7] = bfhi(r.w); }
__device__ __forceinline__ float logsigmoid(float f) { return fminf(f, 0.f) - log1pf(expf(-fabsf(f))); }
__device__ __forceinline__ float frcp(float x) { return __builtin_amdgcn_rcpf(x); }
__device__ __forceinline__ float siluf(float y) { return y * frcp(1.f + __builtin_amdgcn_exp2f(-1.4426950408889634f * y)); }
__device__ __forceinline__ float sigmf(float y) { return frcp(1.f + __builtin_amdgcn_exp2f(-1.4426950408889634f * y)); }
__device__ __forceinline__ int swz(int r, int c) { return r * 128 + ((((c >> 3) ^ r ^ (r >> 3)) & 15) << 3) + (c & 7); }

__device__ __forceinline__ void wave_mm(const LAS bf16_t* A, const LAS bf16_t* B, f32x4 (&acc)[8], int row0, int fr, int fq, int nks, int ntiles) {
#pragma unroll 1
    for (int kk = 0; kk < nks; ++kk) {
        int frl = fr; asm volatile("" : "+v"(frl));
        const int ra = row0 + frl, kb = kk * 4 + fq;
        const bf16x8 a = *(const LAS bf16x8*)(A + ra * 128 + (((kb ^ ra ^ (ra >> 3)) & 15) << 3));
        const int t8 = ((kb ^ frl ^ (frl >> 3)) & 15) << 3;
        const LAS bf16_t* Bb = B + frl * 128;
#pragma unroll
        for (int n = 0; n < 8; ++n) {
            if (n < ntiles) {
                const bf16x8 b = *(const LAS bf16x8*)(Bb + n * 2048 + (t8 ^ (n << 4)));
                acc[n] = __builtin_amdgcn_mfma_f32_16x16x32_bf16(b, a, acc[n], 0, 0, 0);
            }
        }
    }
}

struct EpiP {
    static constexpr bool PERM = true, AFTER_DRAIN = false;
    bf16_t* O;
    __device__ __forceinline__ void operator()(const f32x4 (&acc)[2][2][4][2], const pg8::Unit& u, int wr, int wc, int fr, int fq) const {
        const int row0 = u.pm * 256 + wr * 64 + fr, col0 = u.pn * 256 + wc * 32 + 8 * fq;
        const bool act = u.pn >= 8;
#pragma unroll
        for (int ai = 0; ai < 2; ++ai)
#pragma unroll
            for (int m = 0; m < 4; ++m) { bf16_t* rowp = O + (size_t)(row0 + ai * 128 + m * 16) * NP + col0;
#pragma unroll
                for (int bj = 0; bj < 2; ++bj) { f32x4 v0 = acc[ai][bj][m][0], v1 = acc[ai][bj][m][1];
                    if (act) { f32x2 a = pg8::gelu_pk((f32x2){v0[0], v0[1]}), b = pg8::gelu_pk((f32x2){v0[2], v0[3]}), c = pg8::gelu_pk((f32x2){v1[0], v1[1]}), d = pg8::gelu_pk((f32x2){v1[2], v1[3]});
                        v0 = (f32x4){a.x, a.y, b.x, b.y}; v1 = (f32x4){c.x, c.y, d.x, d.y}; }
                    u32x4 w; w.x = cvt_pk_bf16(v0[0], v0[1]); w.y = cvt_pk_bf16(v0[2], v0[3]); w.z = cvt_pk_bf16(v1[0], v1[1]); w.w = cvt_pk_bf16(v1[2], v1[3]);
                    *(u32x4*)(rowp + bj * 128) = w; } }
    }
};
struct EpiRes {
    static constexpr bool PERM = false, AFTER_DRAIN = false;
    float* C; const float* R;
    __device__ __forceinline__ void operator()(const f32x4 (&acc)[2][2][4][2], const pg8::Unit& u, int wr, int wc, int fr, int fq) const {
        const int row0 = u.pm * 256 + wr * 64 + fr, col0 = u.pn * 256 + wc * 32 + 4 * fq;
#pragma unroll
        for (int ai = 0; ai < 2; ++ai)
#pragma unroll
            for (int m = 0; m < 4; ++m) { const size_t off = (size_t)(row0 + ai * 128 + m * 16) * DM + col0;
#pragma unroll
                for (int bj = 0; bj < 2; ++bj)
#pragma unroll
                    for (int n = 0; n < 2; ++n) { const f32x4 r = *(const f32x4*)(R + off + bj * 128 + n * 16); *(f32x4*)(C + off + bj * 128 + n * 16) = acc[ai][bj][m][n] + ALPHA * r; } }
    }
};
struct EpiResLn {
    static constexpr bool PERM = false, AFTER_DRAIN = false;
    float* C; const float* R; const float* stats; const float* w; const float* b;
    __device__ __forceinline__ void operator()(const f32x4 (&acc)[2][2][4][2], const pg8::Unit& u, int wr, int wc, int fr, int fq) const {
        const int row0 = u.pm * 256 + wr * 64 + fr, col0 = u.pn * 256 + wc * 32 + 4 * fq;
#pragma unroll
        for (int bj = 0; bj < 2; ++bj)
#pragma unroll
            for (int n = 0; n < 2; ++n) { const f32x4 wv = *(const f32x4*)(w + col0 + bj * 128 + n * 16) * ALPHA, bv = *(const f32x4*)(b + col0 + bj * 128 + n * 16) * ALPHA;
#pragma unroll
                for (int ai = 0; ai < 2; ++ai)
#pragma unroll
                    for (int m = 0; m < 4; ++m) { const int row = row0 + ai * 128 + m * 16; const size_t off = (size_t)row * DM + col0 + bj * 128 + n * 16;
                        const f32x2 st = *(const f32x2*)(stats + (size_t)row * 2); const f32x4 r = *(const f32x4*)(R + off);
                        *(f32x4*)(C + off) = acc[ai][bj][m][n] + ((r - st.x) * st.y) * wv + bv; } }
    }
};
struct EpiSwiglu {
    static constexpr bool PERM = true, AFTER_DRAIN = false;
    bf16_t* O;
    __device__ __forceinline__ void operator()(const f32x4 (&acc)[2][2][4][2], const pg8::Unit& u, int wr, int wc, int fr, int fq) const {
        const int row0 = u.pm * 256 + wr * 64 + fr, col0 = u.pn * 128 + wc * 32 + 8 * fq;
#pragma unroll
        for (int ai = 0; ai < 2; ++ai)
#pragma unroll
            for (int m = 0; m < 4; ++m) { bf16_t* rowp = O + (size_t)(row0 + ai * 128 + m * 16) * DFF + col0;
                float h[8];
#pragma unroll
                for (int n = 0; n < 2; ++n)
#pragma unroll
                    for (int j = 0; j < 4; ++j) h[n * 4 + j] = siluf(acc[ai][0][m][n][j]) * acc[ai][1][m][n][j];
                u32x4 w; w.x = cvt_pk_bf16(h[0], h[1]); w.y = cvt_pk_bf16(h[2], h[3]); w.z = cvt_pk_bf16(h[4], h[5]); w.w = cvt_pk_bf16(h[6], h[7]);
                *(u32x4*)rowp = w; }
    }
};

__device__ __forceinline__ void wt_tile(const Params& P, int t, const float*& src, int& lsrc, bf16_t*& dst, int& ldd) {
    unsigned char* ws = P.ws;
    if (t < 384) { const int kt = t / 24, nt = t % 24, n0 = nt * 128; src = P.in[1] + (size_t)kt * 64 * NIN + (n0 < 2048 ? n0 : n0 + 8); lsrc = NIN; dst = (bf16_t*)(ws + WS_WINT) + (size_t)n0 * 1024 + kt * 64; ldd = 1024; }
    else if (t < 512) { const int t2 = t - 384, kt = t2 >> 3, nt = t2 & 7; src = P.in[9] + (size_t)kt * 64 * 1024 + nt * 128; lsrc = 1024; dst = (bf16_t*)(ws + WS_WOUTT) + (size_t)nt * 128 * 1024 + kt * 64; ldd = 1024; }
    else if (t < 1216) { const int t2 = t - 512, kt = t2 / 44, nt = t2 % 44, pn = nt >> 1, bj = nt & 1; src = (bj ? P.in[13] : P.in[12]) + (size_t)kt * 64 * DFF + pn * 128; lsrc = DFF;
        dst = (bf16_t*)(ws + WS_WGUT) + (size_t)nt * 128 * 1024 + kt * 64; ldd = 1024; }
    else { const int t2 = t - 1216, kt = t2 >> 3, nt = t2 & 7; src = P.in[14] + (size_t)kt * 64 * 1024 + nt * 128; lsrc = 1024; dst = (bf16_t*)(ws + WS_WDOWNT) + (size_t)nt * 128 * DFF + kt * 64; ldd = DFF; }
}
__device__ __forceinline__ void wt_phase(const Params& P, LAS unsigned char* lds, int t_begin, int t_end) {
    const int tid = threadIdx.x;
    const int G = (int)gridDim.x;
    LAS float* tile = (LAS float*)lds;
    int t = t_begin + blockIdx.x; f32x4 r[4]; const float* src; int lsrc; bf16_t* dst; int ldd;
    const int lr = tid >> 5, lc = (tid & 31) * 4;
    if (t < t_end) { wt_tile(P, t, src, lsrc, dst, ldd);
#pragma unroll
        for (int i = 0; i < 4; ++i) r[i] = *(const f32x4*)(src + (size_t)(i * 16 + lr) * lsrc + lc); }
    while (t < t_end) {
#pragma unroll
        for (int i = 0; i < 4; ++i) { LAS float* tp = tile + (i * 16 + lr) * 129 + lc; tp[0] = r[i][0]; tp[1] = r[i][1]; tp[2] = r[i][2]; tp[3] = r[i][3]; }
        bf16_t* cdst = dst; const int cldd = ldd;
        const int tn = t + G;
        if (tn < t_end) { wt_tile(P, tn, src, lsrc, dst, ldd);
#pragma unroll
            for (int i = 0; i < 4; ++i) r[i] = *(const f32x4*)(src + (size_t)(i * 16 + lr) * lsrc + lc); }
        __syncthreads();
        { const int n = tid >> 2, ks = (tid & 3) * 16; float v[16];
#pragma unroll
          for (int j = 0; j < 16; ++j) v[j] = tile[(ks + j) * 129 + n];
          u32x4 w0, w1; w0.x = cvt_pk_bf16(v[0], v[1]); w0.y = cvt_pk_bf16(v[2], v[3]); w0.z = cvt_pk_bf16(v[4], v[5]); w0.w = cvt_pk_bf16(v[6], v[7]);
          w1.x = cvt_pk_bf16(v[8], v[9]); w1.y = cvt_pk_bf16(v[10], v[11]); w1.z = cvt_pk_bf16(v[12], v[13]); w1.w = cvt_pk_bf16(v[14], v[15]);
          u32x4* o = (u32x4*)(cdst + (size_t)n * cldd + ks); o[0] = w0; o[1] = w1; }
        __syncthreads();
        t = tn;
    }
}
__device__ __forceinline__ void phase_prep(const Params& P, LAS unsigned char* lds) {
    const int tid = threadIdx.x, lane = tid & 63, wid = __builtin_amdgcn_readfirstlane(tid >> 6);
    unsigned char* ws = P.ws;
    const int G = (int)gridDim.x;
    LAS float* wg = (LAS float*)(lds + 36864);
    for (int i = tid; i < 8192; i += 512) wg[i] = P.in[1][(size_t)(i >> 3) * NIN + 2048 + (i & 7)];
    wt_phase(P, lds, 0, 384);
    __syncthreads();
    bf16_t* xb = (bf16_t*)(ws + WS_XB); float* gates = (float*)(ws + WS_GATES);
    const float bg = P.in[2][lane & 7];
    int row = blockIdx.x * 8 + wid; f32x4 nv[4];
    if (row < T_TOK) {
#pragma unroll
        for (int i = 0; i < 4; ++i) nv[i] = ((const f32x4*)(P.in[0] + (size_t)row * DM))[i * 64 + lane]; }
    while (row < T_TOK) {
        f32x4 cv[4];
#pragma unroll
        for (int i = 0; i < 4; ++i) cv[i] = nv[i];
        const int rown = row + G * 8;
        if (rown < T_TOK) {
#pragma unroll
            for (int i = 0; i < 4; ++i) nv[i] = ((const f32x4*)(P.in[0] + (size_t)rown * DM))[i * 64 + lane]; }
        float a[8];
#pragma unroll
        for (int j = 0; j < 8; ++j) a[j] = 0.f;
#pragma unroll
        for (int i = 0; i < 4; ++i) { const f32x4 v = cv[i]; const int k = (i * 64 + lane) * 4;
            u32x2 w; w.x = cvt_pk_bf16(v[0], v[1]); w.y = cvt_pk_bf16(v[2], v[3]); *(u32x2*)(xb + (size_t)row * DM + k) = w;
#pragma unroll
            for (int e = 0; e < 4; ++e) { const f32x4 w0 = *(const LAS f32x4*)(wg + (k + e) * 8), w1 = *(const LAS f32x4*)(wg + (k + e) * 8 + 4);
                a[0] += v[e] * w0[0]; a[1] += v[e] * w0[1]; a[2] += v[e] * w0[2]; a[3] += v[e] * w0[3]; a[4] += v[e] * w1[0]; a[5] += v[e] * w1[1]; a[6] += v[e] * w1[2]; a[7] += v[e] * w1[3]; } }
#pragma unroll
        for (int j = 0; j < 8; ++j) {
#pragma unroll
            for (int o = 32; o >= 1; o >>= 1) a[j] += __shfl_xor(a[j], o); }
        float r = a[0]; r = (lane == 1) ? a[1] : r; r = (lane == 2) ? a[2] : r; r = (lane == 3) ? a[3] : r; r = (lane == 4) ? a[4] : r; r = (lane == 5) ? a[5] : r; r = (lane == 6) ? a[6] : r; r = (lane == 7) ? a[7] : r;
        if (lane < 8) gates[(size_t)row * 8 + lane] = r + bg;
        row = rown;
    }
    __syncthreads();
}

#define VT_WRITE8(Vt_, raw_, ch_, l_) do { \
    Vt_[swz((ch_) * 8 + 0, (l_))] = (bf16_t)((raw_).x & 0xffffu); Vt_[swz((ch_) * 8 + 1, (l_))] = (bf16_t)((raw_).x >> 16); \
    Vt_[swz((ch_) * 8 + 2, (l_))] = (bf16_t)((raw_).y & 0xffffu); Vt_[swz((ch_) * 8 + 3, (l_))] = (bf16_t)((raw_).y >> 16); \
    Vt_[swz((ch_) * 8 + 4, (l_))] = (bf16_t)((raw_).z & 0xffffu); Vt_[swz((ch_) * 8 + 5, (l_))] = (bf16_t)((raw_).z >> 16); \
    Vt_[swz((ch_) * 8 + 6, (l_))] = (bf16_t)((raw_).w & 0xffffu); Vt_[swz((ch_) * 8 + 7, (l_))] = (bf16_t)((raw_).w >> 16); } while (0)
__device__ __forceinline__ void conv_lds8(const LAS bf16_t* R, int l, int ch, const f32x4 (&w)[4][2], float (&y)[8]) {
#pragma unroll
    for (int i = 0; i < 8; ++i) y[i] = 0.f;
#pragma unroll
    for (int j = 0; j < 4; ++j) { const u32x4 raw = *(const LAS u32x4*)(R + (l + j) * 136 + ch * 8); float x[8]; unpack8(raw, x);
        y[0] += w[j][0][0] * x[0]; y[1] += w[j][0][1] * x[1]; y[2] += w[j][0][2] * x[2]; y[3] += w[j][0][3] * x[3]; y[4] += w[j][1][0] * x[4]; y[5] += w[j][1][1] * x[5]; y[6] += w[j][1][2] * x[6]; y[7] += w[j][1][3] * x[7]; }
#pragma unroll
    for (int i = 0; i < 8; ++i) y[i] = siluf(y[i]);
}
__device__ __forceinline__ void mlstm_local(const Params& P, LAS unsigned char* lds, int task) {
    int tid_ = threadIdx.x; asm volatile("" : "+v"(tid_));
    const int tid = tid_, lane = tid & 63, wid = __builtin_amdgcn_readfirstlane(tid >> 6), fr = lane & 15, fq = lane >> 4;
    const int bh = task >> 6, c = task & 63, b = bh >> 2, h = bh & 3, tok0 = b * SEQ + c * 128, pos0 = c * 128;
    unsigned char* ws = P.ws;
    LAS bf16_t* Vt = (LAS bf16_t*)lds; LAS bf16_t* Kt = (LAS bf16_t*)(lds + 32768); LAS bf16_t* RK = (LAS bf16_t*)(lds + 65536); LAS bf16_t* RQ = (LAS bf16_t*)(lds + 101376);
    LAS float* wsl = (LAS float*)(lds + 137216);
    const float* gates = (const float*)(ws + WS_GATES); const bf16_t* p = (const bf16_t*)(ws + WS_P);
    float gi0 = 0.f, gi1 = 0.f, gf0 = 0.f, gf1 = 0.f;
    if (wid == 0) { const int l0 = 2 * lane; gi0 = gates[(size_t)(tok0 + l0) * 8 + h]; gi1 = gates[(size_t)(tok0 + l0 + 1) * 8 + h]; gf0 = gates[(size_t)(tok0 + l0) * 8 + 4 + h]; gf1 = gates[(size_t)(tok0 + l0 + 1) * 8 + 4 + h]; }
    u32x4 rk[4], rq[4], rv[4], rke = (u32x4){0u, 0u, 0u, 0u}, rqe = (u32x4){0u, 0u, 0u, 0u};
#pragma unroll
    for (int j = 0; j < 4; ++j) { const int i = tid + 512 * j, r = i >> 4, cb = i & 15; const bool valid = pos0 - 3 + r >= 0;
        const bf16_t* src = p + (size_t)(tok0 - 3 + r) * NP + h * 128 + cb * 8;
        rk[j] = (u32x4){0u, 0u, 0u, 0u}; rq[j] = (u32x4){0u, 0u, 0u, 0u};
        if (valid) { rq[j] = *(const u32x4*)src; rk[j] = *(const u32x4*)(src + 512); } }
    if (tid < 48) { const int r = 128 + (tid >> 4), cb = tid & 15; const bf16_t* src = p + (size_t)(tok0 - 3 + r) * NP + h * 128 + cb * 8; rqe = *(const u32x4*)src; rke = *(const u32x4*)(src + 512); }
#pragma unroll
    for (int it = 0; it < 4; ++it) { const int l = it * 32 + wid * 4 + (lane & 3), ch = lane >> 2; rv[it] = *(const u32x4*)(p + (size_t)(tok0 + l) * NP + 1024 + h * 128 + ch * 8); }
    if (wid == 0) {
        const int l0 = 2 * lane;
        const float lf0 = logsigmoid(gf0), lf1 = logsigmoid(gf1);
        const float s1 = lf0 + lf1; float tot = s1;
#pragma unroll
        for (int o = 1; o < 64; o <<= 1) { const float t = __shfl_up(tot, o); if (lane >= o) tot += t; }
        const float ex = tot - s1, b0 = ex + lf0, b1 = ex + s1, g = __shfl(tot, 63);
        const float w0 = g - b0 + gi0, w1 = g - b1 + gi1; float mx = fmaxf(w0, w1);
#pragma unroll
        for (int o = 32; o >= 1; o >>= 1) mx = fmaxf(mx, __shfl_xor(mx, o));
        wsl[l0] = __expf(w0 - mx); wsl[l0 + 1] = __expf(w1 - mx);
        if (lane == 0) { ((float*)(ws + WS_SMALL + SM_GTOT))[task] = g; ((float*)(ws + WS_SMALL + SM_MLOC))[task] = mx; }
    }
#pragma unroll
    for (int j = 0; j < 4; ++j) { const int i = tid + 512 * j, r = i >> 4, cb = i & 15; *(LAS u32x4*)(RK + r * 136 + cb * 8) = rk[j]; *(LAS u32x4*)(RQ + r * 136 + cb * 8) = rq[j]; }
    if (tid < 48) { const int r = 128 + (tid >> 4), cb = tid & 15; *(LAS u32x4*)(RK + r * 136 + cb * 8) = rke; *(LAS u32x4*)(RQ + r * 136 + cb * 8) = rqe; }
#pragma unroll
    for (int it = 0; it < 4; ++it) { const int l = it * 32 + wid * 4 + (lane & 3), ch = lane >> 2; VT_WRITE8(Vt, rv[it], ch, l); }
    __syncthreads();
    {   const int ch = lane >> 2; f32x4 w[4][2];
        const float* cw = P.in[3] + 512 + h * 128 + ch * 8;
#pragma unroll
        for (int j = 0; j < 4; ++j) { w[j][0] = *(const f32x4*)(cw + j * 1024); w[j][1] = *(const f32x4*)(cw + j * 1024 + 4); }
        bf16_t* KC = (bf16_t*)(ws + WS_KC);
#pragma unroll
        for (int it = 0; it < 4; ++it) { const int l = it * 32 + wid * 4 + (lane & 3); float y[8]; conv_lds8(RK, l, ch, w, y);
            const float sc = 0.08838834764831845f, wl = wsl[l];
#pragma unroll
            for (int i = 0; i < 8; ++i) { y[i] *= sc; Kt[swz(ch * 8 + i, l)] = f2bf(y[i] * wl); }
            u32x4 o; o.x = cvt_pk_bf16(y[0], y[1]); o.y = cvt_pk_bf16(y[2], y[3]); o.z = cvt_pk_bf16(y[4], y[5]); o.w = cvt_pk_bf16(y[6], y[7]);
            *(u32x4*)(KC + (size_t)(tok0 + l) * 512 + h * 128 + ch * 8) = o; }
        cw = P.in[3] + h * 128 + ch * 8;
#pragma unroll
        for (int j = 0; j < 4; ++j) { w[j][0] = *(const f32x4*)(cw + j * 1024); w[j][1] = *(const f32x4*)(cw + j * 1024 + 4); }
        bf16_t* QC = (bf16_t*)(ws + WS_QC);
#pragma unroll
        for (int it = 0; it < 4; ++it) { const int l = it * 32 + wid * 4 + (lane & 3); float y[8]; conv_lds8(RQ, l, ch, w, y);
            u32x4 o; o.x = cvt_pk_bf16(y[0], y[1]); o.y = cvt_pk_bf16(y[2], y[3]); o.z = cvt_pk_bf16(y[4], y[5]); o.w = cvt_pk_bf16(y[6], y[7]);
            *(u32x4*)(QC + (size_t)(tok0 + l) * 512 + h * 128 + ch * 8) = o; }
    }
    __syncthreads();
    f32x4 acc[8];
#pragma unroll
    for (int n = 0; n < 8; ++n) acc[n] = (f32x4){0.f, 0.f, 0.f, 0.f};
    wave_mm(Vt, Kt, acc, wid * 16, fr, fq, 4, 8);
    float* dC = (float*)(ws + WS_DC) + (size_t)task * 16384 + (wid * 16 + fr) * 128 + fq * 4;
#pragma unroll
    for (int n = 0; n < 8; ++n) *(f32x4*)(dC + n * 16) = acc[n];
    if (tid < 128) { float s = 0.f;
#pragma unroll
        for (int blk = 0; blk < 16; ++blk) { const u32x4 r = *(const LAS u32x4*)(Kt + tid * 128 + blk * 8); float x[8]; unpack8(r, x); s += ((x[0] + x[1]) + (x[2] + x[3])) + ((x[4] + x[5]) + (x[6] + x[7])); }
        ((float*)(ws + WS_SMALL + SM_DN))[task * 128 + tid] = s; }
    __syncthreads();
}

__device__ __forceinline__ void sgu_task(const Params& P, LAS unsigned char* lds, int task) {
    int tid_ = threadIdx.x; asm volatile("" : "+v"(tid_));
    const int tid = tid_, lane = tid & 63, wid = __builtin_amdgcn_readfirstlane(tid >> 6), fr = lane & 15, fq = lane >> 4;
    const int b = task >> 8, c = (task >> 2) & 63, g = task & 3, tok0 = b * SEQ + c * 128;
    unsigned char* ws = P.ws;
    LAS bf16_t* Wl = (LAS bf16_t*)lds; LAS bf16_t* Vst = (LAS bf16_t*)(lds + 32768);
    const bf16_t* p = (const bf16_t*)(ws + WS_P);
    f32x4 wa[4], wb[4]; u32x4 rv[4]; u32x2 ur[8];
#pragma unroll
    for (int it = 0; it < 4; ++it) { const int i = it * 512 + tid, t = i >> 4, sb = i & 15; const float* src = P.in[7] + (size_t)g * 16384 + t * 128 + sb * 8; wa[it] = *(const f32x4*)src; wb[it] = *(const f32x4*)(src + 4); }
#pragma unroll
    for (int it = 0; it < 4; ++it) { const int l = it * 32 + wid * 4 + (lane & 3), ch = lane >> 2; rv[it] = *(const u32x4*)(p + (size_t)(tok0 + l) * NP + 2560 + g * 128 + ch * 8); }
    { const bf16_t* up = p + (size_t)(tok0 + wid * 16 + fr) * NP + 2048 + g * 128 + fq * 4;
#pragma unroll
      for (int n = 0; n < 8; ++n) ur[n] = *(const u32x2*)(up + n * 16); }
    const float bsp = P.in[8][g * 128 + wid * 16 + fr];
#pragma unroll
    for (int it = 0; it < 4; ++it) {
        const int i = it * 512 + tid, t = i >> 4, sb = i & 15, s0 = sb * 8;
        float v[8] = {wa[it][0], wa[it][1], wa[it][2], wa[it][3], wb[it][0], wb[it][1], wb[it][2], wb[it][3]};
#pragma unroll
        for (int e = 0; e < 8; ++e) v[e] = (s0 + e <= t) ? v[e] : 0.f;
        u32x4 w; w.x = cvt_pk_bf16(v[0], v[1]); w.y = cvt_pk_bf16(v[2], v[3]); w.z = cvt_pk_bf16(v[4], v[5]); w.w = cvt_pk_bf16(v[6], v[7]);
        *(LAS u32x4*)(Wl + swz(t, s0)) = w;
    }
    { const int ch = lane >> 2; const float* nwp = P.in[5] + g * 128 + ch * 8; const float* nbp = P.in[6] + g * 128 + ch * 8;
      const f32x4 nw0 = *(const f32x4*)nwp, nw1 = *(const f32x4*)(nwp + 4), nb0 = *(const f32x4*)nbp, nb1 = *(const f32x4*)(nbp + 4);
      const float nw[8] = {nw0[0], nw0[1], nw0[2], nw0[3], nw1[0], nw1[1], nw1[2], nw1[3]}; const float nb[8] = {nb0[0], nb0[1], nb0[2], nb0[3], nb1[0], nb1[1], nb1[2], nb1[3]};
#pragma unroll
      for (int it = 0; it < 4; ++it) {
        const int l = it * 32 + wid * 4 + (lane & 3);
        float x[8]; unpack8(rv[it], x);
        float s = ((x[0] + x[1]) + (x[2] + x[3])) + ((x[4] + x[5]) + (x[6] + x[7]));
        s += __shfl_xor(s, 4); s += __shfl_xor(s, 8); s += __shfl_xor(s, 16); s += __shfl_xor(s, 32);
        const float mu = s * (1.f / 128.f); float q = 0.f;
#pragma unroll
        for (int e = 0; e < 8; ++e) { x[e] -= mu; q += x[e] * x[e]; }
        q += __shfl_xor(q, 4); q += __shfl_xor(q, 8); q += __shfl_xor(q, 16); q += __shfl_xor(q, 32);
        const float rstd = rsqrtf(q * (1.f / 128.f) + LN_EPS);
#pragma unroll
        for (int e = 0; e < 8; ++e) Vst[swz(ch * 8 + e, l)] = f2bf(x[e] * rstd * nw[e] + nb[e]);
      } }
    __syncthreads();
    f32x4 acc[8];
#pragma unroll
    for (int n = 0; n < 8; ++n) acc[n] = (f32x4){0.f, 0.f, 0.f, 0.f};
    wave_mm(Wl, Vst, acc, wid * 16, fr, fq, (wid >> 1) + 1, 8);
    { const int t = wid * 16 + fr, tok = tok0 + t;
      bf16_t* yp = (bf16_t*)(ws + WS_Y) + (size_t)tok * DM + 512 + g * 128 + fq * 4;
#pragma unroll
      for (int n = 0; n < 8; ++n) {
          u32x2 w; w.x = cvt_pk_bf16(bflo(ur[n].x) * (acc[n][0] + bsp), bfhi(ur[n].x) * (acc[n][1] + bsp)); w.y = cvt_pk_bf16(bflo(ur[n].y) * (acc[n][2] + bsp), bfhi(ur[n].y) * (acc[n][3] + bsp));
          *(u32x2*)(yp + n * 16) = w; } }
    __syncthreads();
}

__device__ __forceinline__ void phase_scan(const Params& P) {
    unsigned char* ws = P.ws;
    const float* __restrict__ gt = (const float*)(ws + WS_SMALL + SM_GTOT); const float* __restrict__ ml = (const float*)(ws + WS_SMALL + SM_MLOC);
    const float* __restrict__ dC = (const float*)(ws + WS_DC); unsigned* __restrict__ Cp = (unsigned*)(ws + WS_CPREV);
    for (int idx = blockIdx.x * 512 + threadIdx.x; idx < 8 * 8192; idx += gridDim.x * 512) {
        const int bh = idx >> 13, e = (idx & 8191) * 2;
        float m = 0.f, c0 = 0.f, c1 = 0.f;
#pragma unroll 1
        for (int cb = 0; cb < 64; cb += 16) {
            f32x2 d[16]; float g[16], l[16];
#pragma unroll
            for (int i = 0; i < 16; ++i) { const int task = bh * 64 + cb + i; d[i] = *(const f32x2*)(dC + (size_t)task * 16384 + e); g[i] = gt[task]; l[i] = ml[task]; }
#pragma unroll
            for (int i = 0; i < 16; ++i) { const int task = bh * 64 + cb + i;
                Cp[((size_t)task * 16384 + e) >> 1] = cvt_pk_bf16(c0, c1);
                const float mn = fmaxf(g[i] + m, l[i]), dec = __expf(g[i] + m - mn), sc = __expf(l[i] - mn);
                c0 = dec * c0 + sc * d[i].x; c1 = dec * c1 + sc * d[i].y; m = mn; }
        }
    }
    const float* __restrict__ dn = (const float*)(ws + WS_SMALL + SM_DN); float* __restrict__ np = (float*)(ws + WS_SMALL + SM_NPREV); float* __restrict__ mp = (float*)(ws + WS_SMALL + SM_MPREV);
    for (int idx = blockIdx.x * 512 + threadIdx.x; idx < 8 * 128; idx += gridDim.x * 512) {
        const int bh = idx >> 7, k = idx & 127;
        float m = 0.f, n = 0.f;
#pragma unroll 1
        for (int cb = 0; cb < 64; cb += 16) {
            float d[16], g[16], l[16];
#pragma unroll
            for (int i = 0; i < 16; ++i) { const int task = bh * 64 + cb + i; d[i] = dn[task * 128 + k]; g[i] = gt[task]; l[i] = ml[task]; }
#pragma unroll
            for (int i = 0; i < 16; ++i) { const int task = bh * 64 + cb + i;
                np[task * 128 + k] = n; if (k == 0) mp[task] = m;
                const float mn = fmaxf(g[i] + m, l[i]), dec = __expf(g[i] + m - mn), sc = __expf(l[i] - mn);
                n = dec * n + sc * d[i]; m = mn; }
        }
    }
}

__device__ __forceinline__ void mlstm_out(const Params& P, LAS unsigned char* lds, int task) {
    int tid_ = threadIdx.x; asm volatile("" : "+v"(tid_));
    const int tid = tid_, lane = tid & 63, wid = __builtin_amdgcn_readfirstlane(tid >> 6), fr = lane & 15, fq = lane >> 4;
    const int bh = task >> 6, c = task & 63, b = bh >> 2, h = bh & 3, tok0 = b * SEQ + c * 128;
    unsigned char* ws = P.ws;
    LAS bf16_t* Ql = (LAS bf16_t*)lds; LAS bf16_t* Kl = (LAS bf16_t*)(lds + 32768); LAS bf16_t* Vt = (LAS bf16_t*)(lds + 65536); LAS bf16_t* Cl = (LAS bf16_t*)(lds + 98304);
    LAS float* ibl = (LAS float*)(lds + 131072); LAS float* mjl = ibl + 128; LAS float* al = ibl + 256; LAS float* rcl = ibl + 384; LAS float* nl = ibl + 512;
    const float* gates = (const float*)(ws + WS_GATES); const bf16_t* p = (const bf16_t*)(ws + WS_P);
#ifdef REP_LOAD4
    for (int rl_ = 0; rl_ < REP_LOAD4; ++rl_) { asm volatile("" ::: "memory");
#else
    {
#endif
    float gi0 = 0.f, gi1 = 0.f, gf0 = 0.f, gf1 = 0.f, mprev = 0.f, n0v = 0.f, n1v = 0.f;
    if (wid == 0) { const int l0 = 2 * lane; gi0 = gates[(size_t)(tok0 + l0) * 8 + h]; gi1 = gates[(size_t)(tok0 + l0 + 1) * 8 + h]; gf0 = gates[(size_t)(tok0 + l0) * 8 + 4 + h]; gf1 = gates[(size_t)(tok0 + l0 + 1) * 8 + 4 + h];
        mprev = ((const float*)(ws + WS_SMALL + SM_MPREV))[task]; }
    else if (wid == 1) { n0v = ((const float*)(ws + WS_SMALL + SM_NPREV))[task * 128 + lane]; n1v = ((const float*)(ws + WS_SMALL + SM_NPREV))[task * 128 + lane + 64]; }
    u32x4 rq[4], rk[4], rv[4], rcv[4];
#pragma unroll
    for (int it = 0; it < 4; ++it) { const int i = it * 512 + tid, l = i >> 4, cb = i & 15;
        rq[it] = *(const u32x4*)((const bf16_t*)(ws + WS_QC) + (size_t)(tok0 + l) * 512 + h * 128 + cb * 8);
        rk[it] = *(const u32x4*)((const bf16_t*)(ws + WS_KC) + (size_t)(tok0 + l) * 512 + h * 128 + cb * 8);
        rcv[it] = *(const u32x4*)((const bf16_t*)(ws + WS_CPREV) + (size_t)task * 16384 + l * 128 + cb * 8); }
#pragma unroll
    for (int it = 0; it < 4; ++it) { const int l = it * 32 + wid * 4 + (lane & 3), ch = lane >> 2; rv[it] = *(const u32x4*)(p + (size_t)(tok0 + l) * NP + 1024 + h * 128 + ch * 8); }
    if (wid == 0) {
        const int l0 = 2 * lane;
        const float lf0 = logsigmoid(gf0), lf1 = logsigmoid(gf1);
        const float s1 = lf0 + lf1; float tot = s1;
#pragma unroll
        for (int o = 1; o < 64; o <<= 1) { const float t = __shfl_up(tot, o); if (lane >= o) tot += t; }
        const float ex = tot - s1, b0 = ex + lf0, b1 = ex + s1;
        const float ib0 = gi0 - b0, ib1 = gi1 - b1; const float pl = fmaxf(ib0, ib1); float pm = pl;
#pragma unroll
        for (int o = 1; o < 64; o <<= 1) { const float t = __shfl_up(pm, o); if (lane >= o) pm = fmaxf(pm, t); }
        float pex = __shfl_up(pm, 1); if (lane == 0) pex = -INFINITY;
        const float pm0 = fmaxf(pex, ib0), pm1 = fmaxf(pex, pl);
        const float mj0 = b0 + fmaxf(mprev, pm0), mj1 = b1 + fmaxf(mprev, pm1);
        const float L2E = 1.4426950408889634f;
        ibl[l0] = ib0 * L2E; ibl[l0 + 1] = ib1 * L2E; mjl[l0] = mj0; mjl[l0 + 1] = mj1;
        al[l0] = __expf(b0 + mprev - mj0); al[l0 + 1] = __expf(b1 + mprev - mj1); rcl[l0] = (b0 - mj0) * L2E; rcl[l0 + 1] = (b1 - mj1) * L2E;
    } else if (wid == 1) { nl[lane] = n0v; nl[lane + 64] = n1v; }
#pragma unroll
    for (int it = 0; it < 4; ++it) { const int i = it * 512 + tid, l = i >> 4, cb = i & 15;
        *(LAS u32x4*)(Ql + swz(l, cb * 8)) = rq[it]; *(LAS u32x4*)(Kl + swz(l, cb * 8)) = rk[it]; *(LAS u32x4*)(Cl + swz(l, cb * 8)) = rcv[it]; }
#pragma unroll
    for (int it = 0; it < 4; ++it) { const int l = it * 32 + wid * 4 + (lane & 3), ch = lane >> 2; VT_WRITE8(Vt, rv[it], ch, l); }
    __syncthreads();
    }
    const int l = wid * 16 + fr;
    f32x4 acc[8];
#pragma unroll
    for (int n = 0; n < 8; ++n) acc[n] = (f32x4){0.f, 0.f, 0.f, 0.f};
    wave_mm(Ql, Kl, acc, wid * 16, fr, fq, 4, wid + 1);
    const float rc = rcl[l];
    float rs = 0.f;
#pragma unroll
    for (int n = 0; n < 8; ++n) {
        if (n < wid) { const f32x4 ib4 = *(const LAS f32x4*)(ibl + n * 16 + fq * 4);
#pragma unroll
            for (int j = 0; j < 4; ++j) { const float v = acc[n][j] * __builtin_amdgcn_exp2f(rc + ib4[j]); acc[n][j] = v; rs += v; } }
        else if (n == wid) { const f32x4 ib4 = *(const LAS f32x4*)(ibl + n * 16 + fq * 4);
#pragma unroll
            for (int j = 0; j < 4; ++j) { const int s = n * 16 + fq * 4 + j; const float w = (s <= l) ? __builtin_amdgcn_exp2f(rc + ib4[j]) : 0.f; const float v = acc[n][j] * w; acc[n][j] = v; rs += v; } }
    }
    rs += __shfl_xor(rs, 16); rs += __shfl_xor(rs, 32);
    float nq = 0.f;
#pragma unroll
    for (int blk = 0; blk < 4; ++blk) { const int kb = fq * 4 + blk; const u32x4 r = *(const LAS u32x4*)(Ql + swz(l, kb * 8)); float x[8]; unpack8(r, x);
#pragma unroll
        for (int e = 0; e < 8; ++e) nq += x[e] * nl[kb * 8 + e]; }
    nq += __shfl_xor(nq, 16); nq += __shfl_xor(nq, 32);
    __syncthreads();
#pragma unroll
    for (int n = 0; n < 8; ++n) { u32x2 w; w.x = cvt_pk_bf16(acc[n][0], acc[n][1]); w.y = cvt_pk_bf16(acc[n][2], acc[n][3]); *(LAS u32x2*)(Kl + swz(l, n * 16 + fq * 4)) = w; }
    __syncthreads();
    const float a = al[l], mj = mjl[l];
#pragma unroll
    for (int n = 0; n < 8; ++n) acc[n] = (f32x4){0.f, 0.f, 0.f, 0.f};
    wave_mm(Ql, Cl, acc, wid * 16, fr, fq, 4, 8);
#pragma unroll
    for (int n = 0; n < 8; ++n) acc[n] *= a;
    wave_mm(Kl, Vt, acc, wid * 16, fr, fq, (wid >> 1) + 1, 8);
    const float den = rs + a * nq, hd = fmaxf(fabsf(den), __expf(-mj)), inv = 1.f / hd;
    float sum = 0.f;
#pragma unroll
    for (int n = 0; n < 8; ++n) { acc[n] *= inv; sum += (acc[n][0] + acc[n][1]) + (acc[n][2] + acc[n][3]); }
    sum += __shfl_xor(sum, 16); sum += __shfl_xor(sum, 32);
    const float mu = sum * (1.f / 128.f); float q = 0.f;
#pragma unroll
    for (int n = 0; n < 8; ++n) { acc[n] -= mu; q += (acc[n][0] * acc[n][0] + acc[n][1] * acc[n][1]) + (acc[n][2] * acc[n][2] + acc[n][3] * acc[n][3]); }
    q += __shfl_xor(q, 16); q += __shfl_xor(q, 32);
    const float rstd = rsqrtf(q * (1.f / 128.f) + LN_EPS);
    { const int tok = tok0 + l; const float* nw = P.in[4] + h * 128 + fq * 4; const bf16_t* ogp = p + (size_t)tok * NP + 1536 + h * 128 + fq * 4;
      bf16_t* yp = (bf16_t*)(ws + WS_Y) + (size_t)tok * DM + h * 128 + fq * 4;
#pragma unroll
      for (int n = 0; n < 8; ++n) { const u32x2 orw = *(const u32x2*)(ogp + n * 16); const f32x4 w4 = *(const f32x4*)(nw + n * 16);
          const float o0 = sigmf(bflo(orw.x)), o1 = sigmf(bfhi(orw.x)), o2 = sigmf(bflo(orw.y)), o3 = sigmf(bfhi(orw.y));
          u32x2 w; w.x = cvt_pk_bf16(o0 * acc[n][0] * rstd * w4[0], o1 * acc[n][1] * rstd * w4[1]); w.y = cvt_pk_bf16(o2 * acc[n][2] * rstd * w4[2], o3 * acc[n][3] * rstd * w4[3]);
          *(u32x2*)(yp + n * 16) = w; } }
    __syncthreads();
}

__device__ __forceinline__ void phase_ln(const float* in, float* outf, bf16_t* outb, float* stats, const float* w, const float* bsrc) {
    const int lane = threadIdx.x & 63, wid = threadIdx.x >> 6;
    f32x4 wv[4], bv[4];
#pragma unroll
    for (int i = 0; i < 4; ++i) { wv[i] = *(const f32x4*)(w + (i * 64 + lane) * 4); bv[i] = *(const f32x4*)(bsrc + (i * 64 + lane) * 4); }
    for (int row = blockIdx.x * 8 + wid; row < T_TOK; row += gridDim.x * 8) {
        const f32x4* xr = (const f32x4*)(in + (size_t)row * DM); f32x4 v[4]; float s = 0.f;
#pragma unroll
        for (int i = 0; i < 4; ++i) { v[i] = xr[i * 64 + lane]; s += (v[i][0] + v[i][1]) + (v[i][2] + v[i][3]); }
#pragma unroll
        for (int o = 32; o >= 1; o >>= 1) s += __shfl_xor(s, o);
        const float mu = s * (1.f / 1024.f); float q = 0.f;
#pragma unroll
        for (int i = 0; i < 4; ++i) { v[i] -= mu; q += (v[i][0] * v[i][0] + v[i][1] * v[i][1]) + (v[i][2] * v[i][2] + v[i][3] * v[i][3]); }
#pragma unroll
        for (int o = 32; o >= 1; o >>= 1) q += __shfl_xor(q, o);
        const float rstd = rsqrtf(q * (1.f / 1024.f) + LN_EPS);
        if (stats && lane == 0) { f32x2 st; st.x = mu; st.y = rstd; *(f32x2*)(stats + (size_t)row * 2) = st; }
#pragma unroll
        for (int i = 0; i < 4; ++i) { const f32x4 y = v[i] * rstd * wv[i] + bv[i];
            if (outf) *(f32x4*)(outf + (size_t)row * DM + (i * 64 + lane) * 4) = y;
            if (outb) { u32x2 pk; pk.x = cvt_pk_bf16(y[0], y[1]); pk.y = cvt_pk_bf16(y[2], y[3]); *(u32x2*)(outb + (size_t)row * DM + (i * 64 + lane) * 4) = pk; } }
    }
}

#ifndef REP_G1
#define REP_G1 1
#endif
#ifndef REP_G2
#define REP_G2 1
#endif
#ifndef REP_G3
#define REP_G3 1
#endif
#ifndef REP_G4
#define REP_G4 1
#endif
#ifndef REP_LN
#define REP_LN 0
#endif
#ifndef REP_ML
#define REP_ML 1
#endif
#ifndef REP_SGU
#define REP_SGU 1
#endif
#ifndef REP_PREP
#define REP_PREP 1
#endif
#ifndef REP_P2
#define REP_P2 1
#endif
#ifndef REP_P3
#define REP_P3 1
#endif
#ifndef REP_P4
#define REP_P4 1
#endif
__global__ void __launch_bounds__(512, 2) fwd_megakernel(Params P) {
    extern __shared__ __attribute__((aligned(16))) unsigned char shm[];
    LAS unsigned char* lds = (LAS unsigned char*)shm;
    cg::grid_group grid = cg::this_grid();
    unsigned char* ws = P.ws;
    const int G = (int)gridDim.x, bx = (int)blockIdx.x;
    volatile LAS unsigned* xst = (volatile LAS unsigned*)(lds + LDS_BYTES - 16);
    if (threadIdx.x < 4) xst[threadIdx.x] = 0u;
    __syncthreads();
    const bool use_cg = G > 1024;
    XcdBarrier xbar = xcd_barrier_post((unsigned*)(ws + WS_BAR), xst);
#define GRID_SEAM() do { if (use_cg) grid.sync(); else xcd_barrier(xbar); } while (0)

    for (int rep = 0; rep < REP_PREP; ++rep) { phase_prep(P, lds); GRID_SEAM(); }
    for (int rep = 0; rep < REP_G1; ++rep) {
    { pg8::Gemm g{(const bf16_t*)(ws + WS_XB), (const bf16_t*)(ws + WS_WINT), T_TOK, NP, DM}; pg8::StaticOrder S; S.init(T_TOK, NP, G, bx); EpiP E{(bf16_t*)(ws + WS_P)};
      pg8::gemm_phase<EpiP, pg8::StaticOrder, false>(lds, g, S, E, nullptr); }
    GRID_SEAM();
    }
    for (int rep = 0; rep < REP_P2; ++rep) { for (int task = bx; task < 1024; task += G) { if (task < 512) { for (int r2 = 0; r2 < REP_ML; ++r2) mlstm_local(P, lds, task); } else { for (int r2 = 0; r2 < REP_SGU; ++r2) sgu_task(P, lds, task - 512); } }
    GRID_SEAM(); }
    for (int rep = 0; rep < REP_P3; ++rep) { phase_scan(P); wt_phase(P, lds, 384, 1568); GRID_SEAM(); }
    for (int rep = 0; rep < REP_P4; ++rep) { for (int task = bx; task < 512; task += G) mlstm_out(P, lds, task);
    GRID_SEAM(); }
    for (int rep = 0; rep < REP_G2; ++rep) {
    { pg8::Gemm g{(const bf16_t*)(ws + WS_Y), (const bf16_t*)(ws + WS_WOUTT), T_TOK, DM, DM}; pg8::StaticOrder S; S.init(T_TOK, DM, G, bx); EpiRes E{(float*)(ws + WS_R1), P.in[0]};
      pg8::gemm_phase<EpiRes, pg8::StaticOrder, false>(lds, g, S, E, nullptr); }
    GRID_SEAM();
    }
    for (int rep = 0; rep < REP_LN; ++rep) { phase_ln((const float*)(ws + WS_R1), nullptr, (bf16_t*)(ws + WS_HDN + 64 * MiB), (float*)(ws + WS_HDN), P.in[10], P.in[11]); GRID_SEAM(); }
    phase_ln((const float*)(ws + WS_R1), nullptr, (bf16_t*)(ws + WS_H1B), (float*)(ws + WS_SMALL + SM_STATS), P.in[10], P.in[11]);
    GRID_SEAM();
    for (int rep = 0; rep < REP_G3; ++rep) {
    { pg8::Gemm g{(const bf16_t*)(ws + WS_H1B), (const bf16_t*)(ws + WS_WGUT), T_TOK, 2 * DFF, DM}; pg8::StaticOrder S; S.init(T_TOK, 2 * DFF, G, bx); EpiSwiglu E{(bf16_t*)(ws + WS_HDN)};
      pg8::gemm_phase<EpiSwiglu, pg8::StaticOrder, false>(lds, g, S, E, nullptr); }
    GRID_SEAM();
    }
    for (int rep = 0; rep < REP_G4; ++rep) {
    { pg8::Gemm g{(const bf16_t*)(ws + WS_HDN), (const bf16_t*)(ws + WS_WDOWNT), T_TOK, DM, DFF}; pg8::StaticOrder S; S.init(T_TOK, DM, G, bx); EpiResLn E{P.out, (const float*)(ws + WS_R1), (const float*)(ws + WS_SMALL + SM_STATS), P.in[10], P.in[11]};
      pg8::gemm_phase<EpiResLn, pg8::StaticOrder, false>(lds, g, S, E, nullptr); }
    GRID_SEAM();
    }
    phase_ln(P.out, P.out, nullptr, nullptr, P.in[15], P.in[16]);
#ifdef REP_SYNC
    for (int rep = 0; rep < REP_SYNC; ++rep) GRID_SEAM();
#endif
}

extern "C" void kernel_launch(void* const* d_in, const int* in_sizes, int n_in, void* d_out, int out_size, void* d_ws, size_t ws_size, hipStream_t stream) {
    (void)in_sizes; (void)n_in; (void)out_size; (void)ws_size;
    static int grid_blocks = 0;
    if (!grid_blocks) {
        int dev = 0, cus = 0, per_cu = 0;
        hipGetDevice(&dev);
        hipDeviceGetAttribute(&cus, hipDeviceAttributeMultiprocessorCount, dev);
        if (hipFuncSetAttribute((const void*)fwd_megakernel, hipFuncAttributeMaxDynamicSharedMemorySize, LDS_BYTES) != hipSuccess) fprintf(stderr, "hipFuncSetAttribute failed\n");
        if (hipOccupancyMaxActiveBlocksPerMultiprocessor(&per_cu, (const void*)fwd_megakernel, 512, LDS_BYTES) != hipSuccess || per_cu < 1) { fprintf(stderr, "occupancy query failed\n"); per_cu = 1; }
        if (per_cu > 1) per_cu = 1;
        grid_blocks = cus * per_cu;
    }
    Params P{};
    for (int i = 0; i < 17; ++i) P.in[i] = (const float*)d_in[i];
    P.out = (float*)d_out; P.ws = (unsigned char*)d_ws;
    hipMemsetAsync((unsigned char*)d_ws + WS_BAR, 0, XCD_BAR_WORDS * sizeof(unsigned), stream);
    void* args[] = {&P};
    hipError_t e = hipLaunchCooperativeKernel((const void*)fwd_megakernel, dim3(grid_blocks), dim3(512), args, LDS_BYTES, stream);
    if (e != hipSuccess) fprintf(stderr, "cooperative launch failed: %s (grid %d)\n", hipGetErrorString(e), grid_blocks);
}
```

```cpp
#include <hip/hip_runtime.h>
#include <hip/hip_cooperative_groups.h>
#include <cstdio>
#include <cstddef>
namespace cg = cooperative_groups;
namespace pg8 {
#define PG8_LAS __attribute__((address_space(3)))
typedef unsigned short bf16_t;
typedef short bf16x8 __attribute__((ext_vector_type(8)));
typedef float f32x4 __attribute__((ext_vector_type(4)));
typedef unsigned u32x4 __attribute__((ext_vector_type(4)));
constexpr int BM = 256, BK = 64, HALF = 128, HTB = HALF * BK * 2  , STAGE_BYTES = 8 * HTB, NXCD = 8, WGM = 8;

__host__ __device__ __forceinline__ int lds_byte(int r, int c) { const int st = (r >> 4) * 2 + (c >> 5), rr = r & 15, cc = c & 31, ob = rr * 64 + cc * 2; return st * 1024 + (ob ^ (((ob >> 9) & 1) << 5)); }
__host__ __device__ __forceinline__ void stage_rc(int b, int& R, int& C) { const int st = b / 1024, sb = b % 1024, swz = sb ^ (((sb >> 9) & 1) << 5); R = (st >> 1) * 16 + swz / 64; C = (st & 1) * 32 + (swz % 64) / 2; }
__host__ __device__ __forceinline__ int perm32(int rho) { const int n = rho >> 4, i = rho & 15; return 8 * (i >> 2) + 4 * n + (i & 3); }

struct Unit { int pm, pn; };
struct Gemm { const bf16_t* A; const bf16_t* Bt; int M, N, K; };

struct StaticOrder {
    int nM, nN, nwg, G, c;
    __host__ __device__ void init(int M, int N, int G_, int c_) { nM = M / BM; nN = N / BM; nwg = nM * nN; G = G_; c = c_; }
    __host__ __device__ bool next(int i, Unit& u) const {
        const long L = (long)i * G + c; if (L >= nwg) return false;
        int wgid = (int)L; { const int q = nwg / NXCD, r = nwg % NXCD, xcd = wgid % NXCD, off = wgid / NXCD; wgid = (xcd < r ? xcd * (q + 1) : r * (q + 1) + (xcd - r) * q) + off; }
        const int nig = WGM * nN, gid = wgid / nig, fm = gid * WGM, gsz = (nM - fm) < WGM ? (nM - fm) : WGM;
        u.pm = fm + ((wgid % nig) % gsz); u.pn = (wgid % nig) / gsz; return true;
    }
    __device__ __forceinline__ void a_ready(const Unit&) const {}
    __device__ __forceinline__ void done(const Unit&) const {}
};
struct CountedOrder : StaticOrder {
    const unsigned* ready; unsigned need; unsigned* tmo;
    __device__ __forceinline__ void a_ready(const Unit& u) const {
        if (threadIdx.x < 64) {
            const unsigned long long t0 = __builtin_amdgcn_s_memrealtime(); unsigned polls = 0;
            while ((unsigned)__builtin_amdgcn_readfirstlane(__hip_atomic_load(ready + 64 * u.pm, __ATOMIC_RELAXED, __HIP_MEMORY_SCOPE_AGENT)) < need) {
                if ((++polls & 255u) == 0u && __builtin_amdgcn_readfirstlane(__hip_atomic_load(tmo, __ATOMIC_RELAXED, __HIP_MEMORY_SCOPE_AGENT)) != 0u) break;
                if (__builtin_amdgcn_s_memrealtime() - t0 > 2000000ull) {
                    if (threadIdx.x == 0) { unsigned expect = 0u; __hip_atomic_compare_exchange_strong(tmo + 1, &expect, 0x600u | (unsigned)(u.pm & 0xff), __ATOMIC_RELAXED, __ATOMIC_RELAXED, __HIP_MEMORY_SCOPE_AGENT); __hip_atomic_store(tmo, 1u, __ATOMIC_RELAXED, __HIP_MEMORY_SCOPE_AGENT); }
                    break; }
                __builtin_amdgcn_s_sleep(2); }
            __builtin_amdgcn_fence(__ATOMIC_ACQUIRE, "agent");
            asm volatile("s_waitcnt vmcnt(0)" ::: "memory");
        }
#if !defined(BROKEN_HOOK_NO_BARRIER)
        asm volatile("" ::: "memory"); __builtin_amdgcn_s_barrier(); asm volatile("" ::: "memory");
#endif
    }
};

__device__ __forceinline__ unsigned cvt_pk_bf16(float lo, float hi) { unsigned r; asm volatile("v_cvt_pk_bf16_f32 %0, %1, %2" : "=v"(r) : "v"(lo), "v"(hi)); return r; }
typedef float f32x2 __attribute__((ext_vector_type(2)));
__device__ __forceinline__ f32x2 gelu_pk(f32x2 v) {
    const f32x2 av = __builtin_elementwise_abs(v), d = av * 0.2316418882f + 1.0f;
    f32x2 t; t.x = __builtin_amdgcn_rcpf(d.x); t.y = __builtin_amdgcn_rcpf(d.y);
    f32x2 q = t * 0.5307027145f + (-0.7265760135f); q = q * t + 0.7107068705f; q = q * t + (-0.142248368f); q = q * t + 0.127414796f; q = q * t;
    const f32x2 s = (v * v) * (-0.72134752044f);
    f32x2 e; e.x = __builtin_amdgcn_exp2f(s.x); e.y = __builtin_amdgcn_exp2f(s.y);
    const f32x2 m = v * (q * e), r = v - m;
    f32x2 o; o.x = v.x < 0.f ? m.x : r.x; o.y = v.y < 0.f ? m.y : r.y; return o;
}

template <class Epi, class Sched, bool ALIGN_EPI = false, bool SP2 = false>
__device__ __forceinline__ void gemm_phase(PG8_LAS unsigned char* lds, const Gemm g, const Sched& S, const Epi& E) {
    const int tid = threadIdx.x, wid = __builtin_amdgcn_readfirstlane(tid >> 6), lane = tid & 63, wr = wid >> 2, wc = wid & 3, fr = lane & 15, fq = lane >> 4;
    const int K = g.K, nt = K / BK;
    unsigned voffA[2], voffB[2];
#pragma unroll
    for (int i = 0; i < 2; ++i) { int R, C; stage_rc(tid * 16 + i * 8192, R, C); const int Rb = Epi::PERM ? ((R & ~31) + perm32(R & 31)) : R;
        voffA[i] = (unsigned)(R * K + C) * 2u; voffB[i] = (unsigned)(Rb * K + C) * 2u; }
    const size_t kstep = (size_t)(BK * 2);
    const size_t hstep = (size_t)HALF * K * 2;
    const size_t tstep = 2 * hstep;
    const unsigned ldsw = (unsigned)wid * 1024u;
    const int aoff = lds_byte(wr * 64 + fr, fq * 8), boff = lds_byte(wc * 32 + fr, fq * 8);
#define PG8_SA(b, h) (((b) * 2 + (h)) * HTB)
#define PG8_SB(b, h) ((4 + (b) * 2 + (h)) * HTB)
#define PG8_STAGE(bufoff, gbase, voff) do { _Pragma("unroll") for (int _i = 0; _i < 2; ++_i) \
        __builtin_amdgcn_global_load_lds((const unsigned*)((const char*)(gbase) + (voff)[_i]), (PG8_LAS unsigned*)(lds + (bufoff) + ldsw + _i * 8192), 16, 0, 0); } while (0)
#define PG8_LDA(dst, b, h) do { _Pragma("unroll") for (int m = 0; m < 4; ++m) _Pragma("unroll") for (int k = 0; k < 2; ++k) dst[m][k] = *(const PG8_LAS bf16x8*)(lds + PG8_SA(b, h) + aoff + m * 2048 + k * 1024); } while (0)
#define PG8_LDB(dst, b, h) do { _Pragma("unroll") for (int n = 0; n < 2; ++n) _Pragma("unroll") for (int k = 0; k < 2; ++k) dst[n][k] = *(const PG8_LAS bf16x8*)(lds + PG8_SB(b, h) + boff + n * 2048 + k * 1024); } while (0)
#define PG8_MMA(ai, bj, At, Bt) do { __builtin_amdgcn_s_setprio(1); _Pragma("unroll") for (int m = 0; m < 4; ++m) _Pragma("unroll") for (int n = 0; n < 2; ++n) _Pragma("unroll") for (int k = 0; k < 2; ++k) \
        acc[ai][bj][m][n] = __builtin_amdgcn_mfma_f32_16x16x32_bf16(Bt[n][k], At[m][k], acc[ai][bj][m][n], 0, 0, 0); __builtin_amdgcn_s_setprio(0); } while (0)
#define PG8_WAIT_V(n) asm volatile("s_waitcnt vmcnt(" #n ")" ::: "memory")
#define PG8_WAIT_L(n) asm volatile("s_waitcnt lgkmcnt(" #n ")" ::: "memory")
#define PG8_BAR __builtin_amdgcn_s_barrier()
#define PG8_SCHED __builtin_amdgcn_sched_barrier(0)
    Unit cur, nxt; int ui = 0;
    if (!S.next(0, cur)) return;
    f32x4 acc[2][2][4][2];
#pragma unroll
    for (int a = 0; a < 2; ++a)
#pragma unroll
        for (int b = 0; b < 2; ++b)
#pragma unroll
            for (int m = 0; m < 4; ++m)
#pragma unroll
                for (int n = 0; n < 2; ++n) acc[a][b][m][n] = (f32x4){0.f, 0.f, 0.f, 0.f};
    bf16x8 At[4][2], B0[2][2], B1[2][2];
    const char* cA = (const char*)g.A + (size_t)cur.pm * tstep; const char* cB = (const char*)g.Bt + (size_t)cur.pn * tstep;
    S.a_ready(cur);
    if constexpr (SP2) {
        PG8_STAGE(PG8_SB(0, 0), cB, voffB); PG8_STAGE(PG8_SB(0, 1), cB + hstep, voffB); PG8_STAGE(PG8_SA(0, 0), cA, voffA); PG8_STAGE(PG8_SA(0, 1), cA + hstep, voffA);
        if (wr == 1) PG8_BAR;
        PG8_WAIT_V(2); PG8_BAR;
        PG8_STAGE(PG8_SB(1, 0), cB + kstep, voffB); PG8_STAGE(PG8_SA(1, 0), cA + kstep, voffA); PG8_STAGE(PG8_SB(1, 1), cB + hstep + kstep, voffB);
        PG8_WAIT_V(6); PG8_BAR;
    } else {
        PG8_STAGE(PG8_SB(0, 0), cB, voffB); PG8_STAGE(PG8_SA(0, 0), cA, voffA); PG8_STAGE(PG8_SB(0, 1), cB + hstep, voffB); PG8_STAGE(PG8_SA(0, 1), cA + hstep, voffA);
        if (wr == 1) PG8_BAR;
        PG8_WAIT_V(4); PG8_BAR;
        PG8_STAGE(PG8_SB(1, 0), cB + kstep, voffB); PG8_STAGE(PG8_SA(1, 0), cA + kstep, voffA); PG8_STAGE(PG8_SB(1, 1), cB + hstep + kstep, voffB);
        PG8_WAIT_V(6); PG8_BAR;
    }
    for (;;) {
        const bool has_next = S.next(ui + 1, nxt);
        const char* nA = has_next ? (const char*)g.A + (size_t)nxt.pm * tstep : cA; const char* nB = has_next ? (const char*)g.Bt + (size_t)nxt.pn * tstep : cB;
        for (int t = 0; t < nt; t += 2) {
            const bool last = (t == nt - 2);
            const char* a1 = cA + (size_t)(t + 1) * kstep;
            const char* a2 = last ? nA : cA + (size_t)(t + 2) * kstep; const char* b2 = last ? nB : cB + (size_t)(t + 2) * kstep;
            const char* a3 = a2 + kstep; const char* b3 = b2 + kstep;
            if (last && has_next) S.a_ready(nxt);
            if constexpr (SP2) {
            PG8_LDB(B0, 0, 0); PG8_LDB(B1, 0, 1); PG8_SCHED; PG8_LDA(At, 0, 0); PG8_STAGE(PG8_SA(1, 1), a1 + hstep, voffA);
            PG8_WAIT_V(8); PG8_WAIT_L(0); PG8_BAR; PG8_MMA(0, 0, At, B0); PG8_MMA(0, 1, At, B1); PG8_BAR; PG8_SCHED;
            PG8_LDA(At, 0, 1); PG8_STAGE(PG8_SB(0, 0), b2, voffB); PG8_STAGE(PG8_SB(0, 1), b2 + hstep, voffB); PG8_STAGE(PG8_SA(0, 0), a2, voffA);
            PG8_WAIT_V(8); PG8_WAIT_L(0); PG8_BAR; PG8_MMA(1, 0, At, B0); PG8_MMA(1, 1, At, B1); PG8_BAR; PG8_SCHED;
            PG8_LDB(B0, 1, 0); PG8_LDB(B1, 1, 1); PG8_SCHED; PG8_LDA(At, 1, 0); PG8_STAGE(PG8_SA(0, 1), a2 + hstep, voffA);
            PG8_WAIT_V(8); PG8_WAIT_L(0); PG8_BAR; PG8_MMA(0, 0, At, B0); PG8_MMA(0, 1, At, B1); PG8_BAR; PG8_SCHED;
            PG8_LDA(At, 1, 1); PG8_STAGE(PG8_SB(1, 0), b3, voffB); PG8_STAGE(PG8_SB(1, 1), b3 + hstep, voffB); PG8_STAGE(PG8_SA(1, 0), a3, voffA);
            PG8_WAIT_V(8); PG8_WAIT_L(0); PG8_BAR; PG8_MMA(1, 0, At, B0); PG8_MMA(1, 1, At, B1); PG8_BAR; PG8_SCHED;
            } else {
            PG8_LDB(B0, 0, 0); PG8_SCHED; PG8_LDA(At, 0, 0); PG8_STAGE(PG8_SA(1, 1), a1 + hstep, voffA);
            PG8_WAIT_L(8); PG8_BAR; PG8_WAIT_L(0); PG8_MMA(0, 0, At, B0); PG8_BAR; PG8_SCHED;
            PG8_LDB(B1, 0, 1); PG8_STAGE(PG8_SB(0, 0), b2, voffB);
            PG8_BAR; PG8_WAIT_L(0); PG8_MMA(0, 1, At, B1); PG8_BAR;
            PG8_LDA(At, 0, 1); PG8_STAGE(PG8_SA(0, 0), a2, voffA);
            PG8_BAR; PG8_WAIT_L(0); PG8_MMA(1, 0, At, B0); PG8_BAR; PG8_SCHED;
            PG8_STAGE(PG8_SB(0, 1), b2 + hstep, voffB);
            PG8_WAIT_V(6); PG8_BAR; PG8_MMA(1, 1, At, B1); PG8_BAR;
            PG8_LDB(B0, 1, 0); PG8_SCHED; PG8_LDA(At, 1, 0); PG8_STAGE(PG8_SA(0, 1), a2 + hstep, voffA);
            PG8_WAIT_L(8); PG8_BAR; PG8_WAIT_L(0); PG8_MMA(0, 0, At, B0); PG8_BAR; PG8_SCHED;
            PG8_LDB(B1, 1, 1); PG8_STAGE(PG8_SB(1, 0), b3, voffB);
            PG8_BAR; PG8_WAIT_L(0); PG8_MMA(0, 1, At, B1); PG8_BAR;
            PG8_LDA(At, 1, 1); PG8_STAGE(PG8_SA(1, 0), a3, voffA);
            PG8_BAR; PG8_WAIT_L(0); PG8_MMA(1, 0, At, B0); PG8_BAR; PG8_SCHED;
            PG8_STAGE(PG8_SB(1, 1), b3 + hstep, voffB);
            PG8_WAIT_V(6); PG8_BAR; PG8_MMA(1, 1, At, B1); PG8_BAR;
            }
        }
        if constexpr (ALIGN_EPI) { if (wr == 0) PG8_BAR; }
        if constexpr (!Epi::AFTER_DRAIN) { E(acc, cur, wr, wc, fr, fq); S.done(cur); }
        if (!has_next) break;
#pragma unroll
        for (int a = 0; a < 2; ++a)
#pragma unroll
            for (int b = 0; b < 2; ++b)
#pragma unroll
                for (int m = 0; m < 4; ++m)
#pragma unroll
                    for (int n = 0; n < 2; ++n) acc[a][b][m][n] = (f32x4){0.f, 0.f, 0.f, 0.f};
        cur = nxt; cA = nA; cB = nB; ++ui;
        if constexpr (ALIGN_EPI) { if (wr == 1) PG8_BAR; }
    }
    PG8_WAIT_V(0);
    if constexpr (!ALIGN_EPI) { if (wr == 0) PG8_BAR; }
    PG8_BAR;
    if constexpr (Epi::AFTER_DRAIN) { E.fused(acc, cur, wr, wc, fr, fq, lds, wid, lane); S.done(cur); }
#undef PG8_SA
#undef PG8_SB
#undef PG8_STAGE
#undef PG8_LDA
#undef PG8_LDB
#undef PG8_MMA
#undef PG8_WAIT_V
#undef PG8_WAIT_L
#undef PG8_BAR
#undef PG8_SCHED
}
}
#define XB_TMO      128
#define XB_XCNT(j)  (256  + 64 * (j))
#define XB_XSUB(j)  (1280 + 64 * (j))
#define XB_XGEN(j)  (2304 + 64 * (j))
#define XB_TOP      3328
#define XB_TOPGEN   3392
#define XCD_BAR_WORDS 3456
#define XB_SPIN_CAP (1u << 18)
#ifndef LAS
#define LAS __attribute__((address_space(3)))
#endif

__device__ __forceinline__ unsigned xb_ld(unsigned* p)              { return __hip_atomic_load(p, __ATOMIC_RELAXED, __HIP_MEMORY_SCOPE_AGENT); }
__device__ __forceinline__ unsigned xb_add(unsigned* p, unsigned v) { return __hip_atomic_fetch_add(p, v, __ATOMIC_RELAXED, __HIP_MEMORY_SCOPE_AGENT); }
__device__ __forceinline__ unsigned xb_xcc_id() { return (unsigned)__builtin_amdgcn_s_getreg((3 << 11) | 20) & 0xFu; }
#define XB_SPIN(cond, bar) do { unsigned _sp = 0; while (cond) { __builtin_amdgcn_s_sleep(1); \
    if ((++_sp & 255u) == 0u) { if (xb_ld(&(bar)[XB_TMO])) break; if (_sp > XB_SPIN_CAP) { atomicAdd(&(bar)[XB_TMO], 1u); break; } } } } while (0)

struct XcdBarrier {
    unsigned* bar; unsigned x;
    volatile LAS unsigned* st;
};

__device__ __forceinline__ XcdBarrier xcd_barrier_post(unsigned* bar, volatile LAS unsigned* st) {
    XcdBarrier b; b.bar = bar; b.x = xb_xcc_id(); b.st = st;
    if (threadIdx.x == 0) (void)xb_add(&bar[XB_XCNT(b.x)], 1u);
    return b;
}
__device__ __forceinline__ void xcd_barrier_complete(unsigned* bar, unsigned x, unsigned& nloc, unsigned& nx) {
    const unsigned G = gridDim.x * gridDim.y * gridDim.z;
    unsigned sum, cnt, mine, sp = 0u;
    for (;;) {
        sum = 0u; cnt = 0u; mine = 0u;
#pragma unroll
        for (unsigned j = 0; j < 16; ++j) { const unsigned c = xb_ld(&bar[XB_XCNT(j)]); sum += c; cnt += (c > 0u) ? 1u : 0u; mine = (j == x) ? c : mine; }
        if (sum == G) break;
        __builtin_amdgcn_s_sleep(1);
        if ((++sp & 255u) == 0u) { if (xb_ld(&bar[XB_TMO])) break; if (sp > XB_SPIN_CAP) { atomicAdd(&bar[XB_TMO], 1u); break; } }
    }
    nloc = mine > 0u ? mine : 1u; nx = cnt > 0u ? cnt : 1u;
}

__device__ __forceinline__ void xcd_barrier(const XcdBarrier& b) {
    asm volatile("s_waitcnt vmcnt(0)" ::: "memory");
    __syncthreads();
    if (threadIdx.x == 0) {
        unsigned* bar = b.bar;
        __builtin_amdgcn_s_waitcnt(0);
        unsigned nloc = b.st[0], nx = b.st[1];
        if (nloc == 0u) { xcd_barrier_complete(bar, b.x, nloc, nx); b.st[0] = nloc; b.st[1] = nx; }
        const unsigned old = xb_add(&bar[XB_XSUB(b.x)], 1u);
        const unsigned gen = old / nloc;
        if (old + 1u == (gen + 1u) * nloc) {
            __builtin_amdgcn_fence(__ATOMIC_RELEASE, "agent");
            asm volatile("s_waitcnt vmcnt(0)" ::: "memory");
            const unsigned og = xb_add(&bar[XB_TOP], 1u);
            const unsigned tg = og / nx;
            if (og + 1u == (tg + 1u) * nx) xb_add(&bar[XB_TOPGEN], 1u);
            else XB_SPIN(xb_ld(&bar[XB_TOPGEN]) == tg, bar);
            __builtin_amdgcn_fence(__ATOMIC_ACQUIRE, "agent");
            xb_add(&bar[XB_XGEN(b.x)], 1u);
            asm volatile("s_waitcnt vmcnt(0)" ::: "memory");
        } else {
            XB_SPIN(xb_ld(&bar[XB_XGEN(b.x)]) == gen, bar);
            __builtin_amdgcn_fence(__ATOMIC_ACQUIRE, "agent");
            asm volatile("s_waitcnt vmcnt(0)" ::: "memory");
        }
    }
    __syncthreads();
}


using pg8::bf16_t; using pg8::bf16x8; using pg8::f32x4; using pg8::u32x4; using pg8::f32x2; using pg8::cvt_pk_bf16;
#define LAS __attribute__((address_space(3)))
typedef unsigned u32x2 __attribute__((ext_vector_type(2)));

constexpr int T_TOK = 16384, DM = 1024, SEQ = 8192, NP = 3072, DFF = 2816, NIN = 3080;
constexpr float ALPHA = 1.189207115002721f;
constexpr float LN_EPS = 1e-5f;
constexpr size_t MiB = (size_t)1 << 20;
constexpr size_t WS_WINT = 0, WS_WOUTT = 6 * MiB, WS_WGUT = 8 * MiB, WS_WDOWNT = 19 * MiB, WS_GATES = 24 * MiB + 512 * 1024, WS_SMALL = 25 * MiB,
                 WS_P = 26 * MiB, WS_XB = 122 * MiB, WS_DC = 122 * MiB, WS_CPREV = 154 * MiB, WS_Y = 170 * MiB, WS_R1 = 26 * MiB, WS_H1B = 90 * MiB, WS_HDN = 122 * MiB, WS_QC = 202 * MiB, WS_KC = 218 * MiB;
constexpr size_t SM_DN = 0, SM_NPREV = 256 * 1024, SM_MLOC = 512 * 1024, SM_GTOT = 512 * 1024 + 2048, SM_MPREV = 512 * 1024 + 4096, SM_STATS = 800 * 1024;
constexpr int LDS_BYTES = 136 * 1024;
constexpr size_t WS_BAR = 25 * MiB + 768 * 1024;

struct Params { const float* in[17]; float* out; unsigned char* ws; };

__device__ __forceinline__ float bflo(unsigned w) { return __uint_as_float(w << 16); }
__device__ __forceinline__ float bfhi(unsigned w) { return __uint_as_float(w & 0xffff0000u); }
__device__ __forceinline__ unsigned short f2bf(float f) { unsigned u = __float_as_uint(f); u += 0x7fffu + ((u >> 16) & 1u); return (unsigned short)(u >> 16); }
__device__ __forceinline__ void unpack8(const u32x4 r, float (&x)[8]) {
    x[0] = bflo(r.x); x[1] = bfhi(r.x); x[2] = bflo(r.y); x[3] = bfhi(r.y); x[4] = bflo(r.z); x[5] = bfhi(r.z); x[6] = bflo(r.w); x[7] = bfhi(r.w); }
__device__ __forceinline__ float logsigmoid(float f) { return fminf(f, 0.f) - log1pf(expf(-fabsf(f))); }
__device__ __forceinline__ float frcp(float x) { return __builtin_amdgcn_rcpf(x); }
__device__ __forceinline__ float siluf(float y) { return y * frcp(1.f + __builtin_amdgcn_exp2f(-1.4426950408889634f * y)); }
__device__ __forceinline__ float sigmf(float y) { return frcp(1.f + __builtin_amdgcn_exp2f(-1.4426950408889634f * y)); }
__device__ __forceinline__ int swz(int r, int c) { return r * 128 + ((((c >> 3) ^ r ^ (r >> 3)) & 15) << 3) + (c & 7); }

__device__ __forceinline__ void wave_mm(const LAS bf16_t* A, const LAS bf16_t* B, f32x4 (&acc)[8], int row0, int fr, int fq, int nks, int ntiles) {
#pragma unroll 1
    for (int kk = 0; kk < nks; ++kk) {
        int frl = fr; asm volatile("" : "+v"(frl));
        const int ra = row0 + frl, kb = kk * 4 + fq;
        const bf16x8 a = *(const LAS bf16x8*)(A + ra * 128 + (((kb ^ ra ^ (ra >> 3)) & 15) << 3));
        const int t8 = ((kb ^ frl ^ (frl >> 3)) & 15) << 3;
        const LAS bf16_t* Bb = B + frl * 128;
#pragma unroll
        for (int n = 0; n < 8; ++n) {
            if (n < ntiles) {
                const bf16x8 b = *(const LAS bf16x8*)(Bb + n * 2048 + (t8 ^ (n << 4)));
                acc[n] = __builtin_amdgcn_mfma_f32_16x16x32_bf16(b, a, acc[n], 0, 0, 0);
            }
        }
    }
}

struct EpiP {
    static constexpr bool PERM = true, AFTER_DRAIN = false;
    bf16_t* O;
    __device__ __forceinline__ void operator()(const f32x4 (&acc)[2][2][4][2], const pg8::Unit& u, int wr, int wc, int fr, int fq) const {
        const int row0 = u.pm * 256 + wr * 64 + fr, col0 = u.pn * 256 + wc * 32 + 8 * fq;
        const bool act = u.pn >= 8;
#pragma unroll
        for (int ai = 0; ai < 2; ++ai)
#pragma unroll
            for (int m = 0; m < 4; ++m) { bf16_t* rowp = O + (size_t)(row0 + ai * 128 + m * 16) * NP + col0;
#pragma unroll
                for (int bj = 0; bj < 2; ++bj) { f32x4 v0 = acc[ai][bj][m][0], v1 = acc[ai][bj][m][1];
                    if (act) { f32x2 a = pg8::gelu_pk((f32x2){v0[0], v0[1]}), b = pg8::gelu_pk((f32x2){v0[2], v0[3]}), c = pg8::gelu_pk((f32x2){v1[0], v1[1]}), d = pg8::gelu_pk((f32x2){v1[2], v1[3]});
                        v0 = (f32x4){a.x, a.y, b.x, b.y}; v1 = (f32x4){c.x, c.y, d.x, d.y}; }
                    u32x4 w; w.x = cvt_pk_bf16(v0[0], v0[1]); w.y = cvt_pk_bf16(v0[2], v0[3]); w.z = cvt_pk_bf16(v1[0], v1[1]); w.w = cvt_pk_bf16(v1[2], v1[3]);
                    *(u32x4*)(rowp + bj * 128) = w; } }
    }
};
struct EpiRes {
    static constexpr bool PERM = false, AFTER_DRAIN = false;
    float* C; const float* R;
    __device__ __forceinline__ void operator()(const f32x4 (&acc)[2][2][4][2], const pg8::Unit& u, int wr, int wc, int fr, int fq) const {
        const int row0 = u.pm * 256 + wr * 64 + fr, col0 = u.pn * 256 + wc * 32 + 4 * fq;
#pragma unroll
        for (int ai = 0; ai < 2; ++ai)
#pragma unroll
            for (int m = 0; m < 4; ++m) { const size_t off = (size_t)(row0 + ai * 128 + m * 16) * DM + col0;
#pragma unroll
                for (int bj = 0; bj < 2; ++bj)
#pragma unroll
                    for (int n = 0; n < 2; ++n) { const f32x4 r = *(const f32x4*)(R + off + bj * 128 + n * 16); *(f32x4*)(C + off + bj * 128 + n * 16) = acc[ai][bj][m][n] + ALPHA * r; } }
    }
};
struct EpiResLn {
    static constexpr bool PERM = false, AFTER_DRAIN = false;
    float* C; const float* R; const float* stats; const float* w; const float* b;
    __device__ __forceinline__ void operator()(const f32x4 (&acc)[2][2][4][2], const pg8::Unit& u, int wr, int wc, int fr, int fq) const {
        const int row0 = u.pm * 256 + wr * 64 + fr, col0 = u.pn * 256 + wc * 32 + 4 * fq;
#pragma unroll
        for (int bj = 0; bj < 2; ++bj)
#pragma unroll
            for (int n = 0; n < 2; ++n) { const f32x4 wv = *(const f32x4*)(w + col0 + bj * 128 + n * 16) * ALPHA, bv = *(const f32x4*)(b + col0 + bj * 128 + n * 16) * ALPHA;
#pragma unroll
                for (int ai = 0; ai < 2; ++ai)
#pragma unroll
                    for (int m = 0; m < 4; ++m) { const int row = row0 + ai * 128 + m * 16; const size_t off = (size_t)row * DM + col0 + bj * 128 + n * 16;
                        const f32x2 st = *(const f32x2*)(stats + (size_t)row * 2); const f32x4 r = *(const f32x4*)(R + off);
                        *(f32x4*)(C + off) = acc[ai][bj][m][n] + ((r - st.x) * st.y) * wv + bv; } }
    }
};
struct EpiSwiglu {
    static constexpr bool PERM = true, AFTER_DRAIN = false;
    bf16_t* O;
    __device__ __forceinline__ void operator()(const f32x4 (&acc)[2][2][4][2], const pg8::Unit& u, int wr, int wc, int fr, int fq) const {
        const int row0 = u.pm * 256 + wr * 64 + fr, col0 = u.pn * 128 + wc * 32 + 8 * fq;
#pragma unroll
        for (int ai = 0; ai < 2; ++ai)
#pragma unroll
            for (int m = 0; m < 4; ++m) { bf16_t* rowp = O + (size_t)(row0 + ai * 128 + m * 16) * DFF + col0;
                float h[8];
#pragma unroll
                for (int n = 0; n < 2; ++n)
#pragma unroll
                    for (int j = 0; j < 4; ++j) h[n * 4 + j] = siluf(acc[ai][0][m][n][j]) * acc[ai][1][m][n][j];
                u32x4 w; w.x = cvt_pk_bf16(h[0], h[1]); w.y = cvt_pk_bf16(h[2], h[3]); w.z = cvt_pk_bf16(h[4], h[5]); w.w = cvt_pk_bf16(h[6], h[7]);
                *(u32x4*)rowp = w; }
    }
};

__device__ __forceinline__ void wt_tile(const Params& P, int t, const float*& src, int& lsrc, bf16_t*& dst, int& ldd) {
    unsigned char* ws = P.ws;
    if (t < 384) { const int kt = t / 24, nt = t % 24, n0 = nt * 128; src = P.in[1] + (size_t)kt * 64 * NIN + (n0 < 2048 ? n0 : n0 + 8); lsrc = NIN; dst = (bf16_t*)(ws + WS_WINT) + (size_t)n0 * 1024 + kt * 64; ldd = 1024; }
    else if (t < 512) { const int t2 = t - 384, kt = t2 >> 3, nt = t2 & 7; src = P.in[9] + (size_t)kt * 64 * 1024 + nt * 128; lsrc = 1024; dst = (bf16_t*)(ws + WS_WOUTT) + (size_t)nt * 128 * 1024 + kt * 64; ldd = 1024; }
    else if (t < 1216) { const int t2 = t - 512, kt = t2 / 44, nt = t2 % 44, pn = nt >> 1, bj = nt & 1; src = (bj ? P.in[13] : P.in[12]) + (size_t)kt * 64 * DFF + pn * 128; lsrc = DFF;
        dst = (bf16_t*)(ws + WS_WGUT) + (size_t)nt * 128 * 1024 + kt * 64; ldd = 1024; }
    else { const int t2 = t - 1216, kt = t2 >> 3, nt = t2 & 7; src = P.in[14] + (size_t)kt * 64 * 1024 + nt * 128; lsrc = 1024; dst = (bf16_t*)(ws + WS_WDOWNT) + (size_t)nt * 128 * DFF + kt * 64; ldd = DFF; }
}
__device__ __forceinline__ void wt_phase(const Params& P, LAS unsigned char* lds, int t_begin, int t_end) {
    const int tid = threadIdx.x;
    const int G = (int)gridDim.x;
    LAS float* tile = (LAS float*)lds;
    int t = t_begin + blockIdx.x; f32x4 r[4]; const float* src; int lsrc; bf16_t* dst; int ldd;
    const int lr = tid >> 5, lc = (tid & 31) * 4;
    if (t < t_end) { wt_tile(P, t, src, lsrc, dst, ldd);
#pragma unroll
        for (int i = 0; i < 4; ++i) r[i] = *(const f32x4*)(src + (size_t)(i * 16 + lr) * lsrc + lc); }
    while (t < t_end) {
#pragma unroll
        for (int i = 0; i < 4; ++i) { LAS float* tp = tile + (i * 16 + lr) * 129 + lc; tp[0] = r[i][0]; tp[1] = r[i][1]; tp[2] = r[i][2]; tp[3] = r[i][3]; }
        bf16_t* cdst = dst; const int cldd = ldd;
        const int tn = t + G;
        if (tn < t_end) { wt_tile(P, tn, src, lsrc, dst, ldd);
#pragma unroll
            for (int i = 0; i < 4; ++i) r[i] = *(const f32x4*)(src + (size_t)(i * 16 + lr) * lsrc + lc); }
        __syncthreads();
        { const int n = tid >> 2, ks = (tid & 3) * 16; float v[16];
#pragma unroll
          for (int j = 0; j < 16; ++j) v[j] = tile[(ks + j) * 129 + n];
          u32x4 w0, w1; w0.x = cvt_pk_bf16(v[0], v[1]); w0.y = cvt_pk_bf16(v[2], v[3]); w0.z = cvt_pk_bf16(v[4], v[5]); w0.w = cvt_pk_bf16(v[6], v[7]);
          w1.x = cvt_pk_bf16(v[8], v[9]); w1.y = cvt_pk_bf16(v[10], v[11]); w1.z = cvt_pk_bf16(v[12], v[13]); w1.w = cvt_pk_bf16(v[14], v[15]);
          u32x4* o = (u32x4*)(cdst + (size_t)n * cldd + ks); o[0] = w0; o[1] = w1; }
        __syncthreads();
        t = tn;
    }
}
__device__ __forceinline__ void phase_prep(const Params& P, LAS unsigned char* lds) {
    const int tid = threadIdx.x, lane = tid & 63, wid = __builtin_amdgcn_readfirstlane(tid >> 6);
    unsigned char* ws = P.ws;
    const int G = (int)gridDim.x;
    LAS float* wg = (LAS float*)(lds + 36864);
    for (int i = tid; i < 8192; i += 512) wg[i] = P.in[1][(size_t)(i >> 3) * NIN + 2048 + (i & 7)];
    wt_phase(P, lds, 0, 384);
    __syncthreads();
    bf16_t* xb = (bf16_t*)(ws + WS_XB); float* gates = (float*)(ws + WS_GATES);
    f32x2 wr[4][4][4];
#pragma unroll
    for (int i = 0; i < 4; ++i)
#pragma unroll
        for (int e = 0; e < 4; ++e) { const int k = (i * 64 + lane) * 4 + e; const f32x4 w0 = *(const LAS f32x4*)(wg + k * 8), w1 = *(const LAS f32x4*)(wg + k * 8 + 4);
            wr[i][e][0] = (f32x2){w0[0], w0[1]}; wr[i][e][1] = (f32x2){w0[2], w0[3]}; wr[i][e][2] = (f32x2){w1[0], w1[1]}; wr[i][e][3] = (f32x2){w1[2], w1[3]}; }
    const float bg = P.in[2][lane >> 3];
    const int rstep = G * 8;
    const bool hi = (lane & 32) != 0, b4 = (lane & 16) != 0, b3 = (lane & 8) != 0;
#define XROW_LOAD(buf, r_) do { if ((r_) < T_TOK) { _Pragma("unroll") for (int i = 0; i < 4; ++i) buf[i] = ((const f32x4*)(P.in[0] + (size_t)(r_) * DM))[i * 64 + lane]; } } while (0)
#define XROW_DO(buf, r_) do { if ((r_) < T_TOK) { \
        f32x2 a[4]; _Pragma("unroll") for (int j = 0; j < 4; ++j) a[j] = (f32x2){0.f, 0.f}; \
        _Pragma("unroll") for (int i = 0; i < 4; ++i) { const f32x4 v = buf[i]; const int k = (i * 64 + lane) * 4; \
            u32x2 w; w.x = cvt_pk_bf16(v[0], v[1]); w.y = cvt_pk_bf16(v[2], v[3]); *(u32x2*)(xb + (size_t)(r_) * DM + k) = w; \
            _Pragma("unroll") for (int e = 0; e < 4; ++e) { const f32x2 vv = (f32x2){v[e], v[e]}; \
                _Pragma("unroll") for (int j = 0; j < 4; ++j) a[j] += vv * wr[i][e][j]; } } \
        f32x2 k0 = hi ? a[2] : a[0], k1 = hi ? a[3] : a[1]; const f32x2 s0 = hi ? a[0] : a[2], s1 = hi ? a[1] : a[3]; \
        k0.x += __shfl_xor(s0.x, 32); k0.y += __shfl_xor(s0.y, 32); k1.x += __shfl_xor(s1.x, 32); k1.y += __shfl_xor(s1.y, 32); \
        f32x2 k2 = b4 ? k1 : k0; const f32x2 s2 = b4 ? k0 : k1; k2.x += __shfl_xor(s2.x, 16); k2.y += __shfl_xor(s2.y, 16); \
        float k3 = b3 ? k2.y : k2.x; const float s3 = b3 ? k2.x : k2.y; k3 += __shfl_xor(s3, 8); \
        k3 += __shfl_xor(k3, 4); k3 += __shfl_xor(k3, 2); k3 += __shfl_xor(k3, 1); \
        if ((lane & 7) == 0) gates[(size_t)(r_) * 8 + (lane >> 3)] = k3 + bg; } } while (0)
    {
        int row = blockIdx.x * 8 + wid; f32x4 va[4], vb[4];
        XROW_LOAD(va, row); XROW_LOAD(vb, row + rstep);
        for (; row < T_TOK; row += 2 * rstep) {
            XROW_DO(va, row); XROW_LOAD(va, row + 2 * rstep);
            XROW_DO(vb, row + rstep); XROW_LOAD(vb, row + 3 * rstep);
        }
    }
#undef XROW_LOAD
#undef XROW_DO
    __syncthreads();
}

#define VT_WRITE8(Vt_, raw_, ch_, l_) do { \
    Vt_[swz((ch_) * 8 + 0, (l_))] = (bf16_t)((raw_).x & 0xffffu); Vt_[swz((ch_) * 8 + 1, (l_))] = (bf16_t)((raw_).x >> 16); \
    Vt_[swz((ch_) * 8 + 2, (l_))] = (bf16_t)((raw_).y & 0xffffu); Vt_[swz((ch_) * 8 + 3, (l_))] = (bf16_t)((raw_).y >> 16); \
    Vt_[swz((ch_) * 8 + 4, (l_))] = (bf16_t)((raw_).z & 0xffffu); Vt_[swz((ch_) * 8 + 5, (l_))] = (bf16_t)((raw_).z >> 16); \
    Vt_[swz((ch_) * 8 + 6, (l_))] = (bf16_t)((raw_).w & 0xffffu); Vt_[swz((ch_) * 8 + 7, (l_))] = (bf16_t)((raw_).w >> 16); } while (0)
__device__ __forceinline__ void conv_lds8(const LAS bf16_t* R, int l, int ch, const f32x4 (&w)[4][2], float (&y)[8]) {
#pragma unroll
    for (int i = 0; i < 8; ++i) y[i] = 0.f;
#pragma unroll
    for (int j = 0; j < 4; ++j) { const u32x4 raw = *(const LAS u32x4*)(R + (l + j) * 136 + ch * 8); float x[8]; unpack8(raw, x);
        y[0] += w[j][0][0] * x[0]; y[1] += w[j][0][1] * x[1]; y[2] += w[j][0][2] * x[2]; y[3] += w[j][0][3] * x[3]; y[4] += w[j][1][0] * x[4]; y[5] += w[j][1][1] * x[5]; y[6] += w[j][1][2] * x[6]; y[7] += w[j][1][3] * x[7]; }
#pragma unroll
    for (int i = 0; i < 8; ++i) y[i] = siluf(y[i]);
}
__device__ __forceinline__ void mlstm_local(const Params& P, LAS unsigned char* lds, int task) {
    int tid_ = threadIdx.x; asm volatile("" : "+v"(tid_));
    const int tid = tid_, lane = tid & 63, wid = __builtin_amdgcn_readfirstlane(tid >> 6), fr = lane & 15, fq = lane >> 4;
    const int bh = task >> 6, c = task & 63, b = bh >> 2, h = bh & 3, tok0 = b * SEQ + c * 128, pos0 = c * 128;
    unsigned char* ws = P.ws;
    LAS bf16_t* Vt = (LAS bf16_t*)lds; LAS bf16_t* Kt = (LAS bf16_t*)(lds + 32768); LAS bf16_t* RK = (LAS bf16_t*)(lds + 65536); LAS bf16_t* RQ = (LAS bf16_t*)(lds + 101376);
    LAS float* wsl = (LAS float*)(lds + 137216);
    const float* gates = (const float*)(ws + WS_GATES); const bf16_t* p = (const bf16_t*)(ws + WS_P);
    float gi0 = 0.f, gi1 = 0.f, gf0 = 0.f, gf1 = 0.f;
    if (wid == 0) { const int l0 = 2 * lane; gi0 = gates[(size_t)(tok0 + l0) * 8 + h]; gi1 = gates[(size_t)(tok0 + l0 + 1) * 8 + h]; gf0 = gates[(size_t)(tok0 + l0) * 8 + 4 + h]; gf1 = gates[(size_t)(tok0 + l0 + 1) * 8 + 4 + h]; }
    u32x4 rk[4], rq[4], rv[4], rke = (u32x4){0u, 0u, 0u, 0u}, rqe = (u32x4){0u, 0u, 0u, 0u};
#pragma unroll
    for (int j = 0; j < 4; ++j) { const int i = tid + 512 * j, r = i >> 4, cb = i & 15; const bool valid = pos0 - 3 + r >= 0;
        const bf16_t* src = p + (size_t)(tok0 - 3 + r) * NP + h * 128 + cb * 8;
        rk[j] = (u32x4){0u, 0u, 0u, 0u}; rq[j] = (u32x4){0u, 0u, 0u, 0u};
        if (valid) { rq[j] = *(const u32x4*)src; rk[j] = *(const u32x4*)(src + 512); } }
    if (tid < 48) { const int r = 128 + (tid >> 4), cb = tid & 15; const bf16_t* src = p + (size_t)(tok0 - 3 + r) * NP + h * 128 + cb * 8; rqe = *(const u32x4*)src; rke = *(const u32x4*)(src + 512); }
#pragma unroll
    for (int it = 0; it < 4; ++it) { const int l = it * 32 + wid * 4 + (lane & 3), ch = lane >> 2; rv[it] = *(const u32x4*)(p + (size_t)(tok0 + l) * NP + 1024 + h * 128 + ch * 8); }
    if (wid == 0) {
        const int l0 = 2 * lane;
        const float lf0 = logsigmoid(gf0), lf1 = logsigmoid(gf1);
        const float s1 = lf0 + lf1; float tot = s1;
#pragma unroll
        for (int o = 1; o < 64; o <<= 1) { const float t = __shfl_up(tot, o); if (lane >= o) tot += t; }
        const float ex = tot - s1, b0 = ex + lf0, b1 = ex + s1, g = __shfl(tot, 63);
        const float w0 = g - b0 + gi0, w1 = g - b1 + gi1; float mx = fmaxf(w0, w1);
#pragma unroll
        for (int o = 32; o >= 1; o >>= 1) mx = fmaxf(mx, __shfl_xor(mx, o));
        wsl[l0] = __expf(w0 - mx); wsl[l0 + 1] = __expf(w1 - mx);
        if (lane == 0) { ((float*)(ws + WS_SMALL + SM_GTOT))[task] = g; ((float*)(ws + WS_SMALL + SM_MLOC))[task] = mx; }
    }
#pragma unroll
    for (int j = 0; j < 4; ++j) { const int i = tid + 512 * j, r = i >> 4, cb = i & 15; *(LAS u32x4*)(RK + r * 136 + cb * 8) = rk[j]; *(LAS u32x4*)(RQ + r * 136 + cb * 8) = rq[j]; }
    if (tid < 48) { const int r = 128 + (tid >> 4), cb = tid & 15; *(LAS u32x4*)(RK + r * 136 + cb * 8) = rke; *(LAS u32x4*)(RQ + r * 136 + cb * 8) = rqe; }
#pragma unroll
    for (int it = 0; it < 4; ++it) { const int l = it * 32 + wid * 4 + (lane & 3), ch = lane >> 2; VT_WRITE8(Vt, rv[it], ch, l); }
    __syncthreads();
    {   const int ch = lane >> 2; f32x4 w[4][2];
        const float* cw = P.in[3] + 512 + h * 128 + ch * 8;
#pragma unroll
        for (int j = 0; j < 4; ++j) { w[j][0] = *(const f32x4*)(cw + j * 1024); w[j][1] = *(const f32x4*)(cw + j * 1024 + 4); }
        bf16_t* KC = (bf16_t*)(ws + WS_KC);
#pragma unroll
        for (int it = 0; it < 4; ++it) { const int l = it * 32 + wid * 4 + (lane & 3); float y[8]; conv_lds8(RK, l, ch, w, y);
            const float sc = 0.08838834764831845f, wl = wsl[l];
#pragma unroll
            for (int i = 0; i < 8; ++i) { y[i] *= sc; Kt[swz(ch * 8 + i, l)] = f2bf(y[i] * wl); }
            u32x4 o; o.x = cvt_pk_bf16(y[0], y[1]); o.y = cvt_pk_bf16(y[2], y[3]); o.z = cvt_pk_bf16(y[4], y[5]); o.w = cvt_pk_bf16(y[6], y[7]);
            *(u32x4*)(KC + (size_t)(tok0 + l) * 512 + h * 128 + ch * 8) = o; }
        cw = P.in[3] + h * 128 + ch * 8;
#pragma unroll
        for (int j = 0; j < 4; ++j) { w[j][0] = *(const f32x4*)(cw + j * 1024); w[j][1] = *(const f32x4*)(cw + j * 1024 + 4); }
        bf16_t* QC = (bf16_t*)(ws + WS_QC);
#pragma unroll
        for (int it = 0; it < 4; ++it) { const int l = it * 32 + wid * 4 + (lane & 3); float y[8]; conv_lds8(RQ, l, ch, w, y);
            u32x4 o; o.x = cvt_pk_bf16(y[0], y[1]); o.y = cvt_pk_bf16(y[2], y[3]); o.z = cvt_pk_bf16(y[4], y[5]); o.w = cvt_pk_bf16(y[6], y[7]);
            *(u32x4*)(QC + (size_t)(tok0 + l) * 512 + h * 128 + ch * 8) = o; }
    }
    __syncthreads();
    f32x4 acc[8];
#pragma unroll
    for (int n = 0; n < 8; ++n) acc[n] = (f32x4){0.f, 0.f, 0.f, 0.f};
    wave_mm(Vt, Kt, acc, wid * 16, fr, fq, 4, 8);
    float* dC = (float*)(ws + WS_DC) + (size_t)task * 16384 + (wid * 16 + fr) * 128 + fq * 4;
#pragma unroll
    for (int n = 0; n < 8; ++n) *(f32x4*)(dC + n * 16) = acc[n];
    if (tid < 128) { float s = 0.f;
#pragma unroll
        for (int blk = 0; blk < 16; ++blk) { const u32x4 r = *(const LAS u32x4*)(Kt + tid * 128 + blk * 8); float x[8]; unpack8(r, x); s += ((x[0] + x[1]) + (x[2] + x[3])) + ((x[4] + x[5]) + (x[6] + x[7])); }
        ((float*)(ws + WS_SMALL + SM_DN))[task * 128 + tid] = s; }
    __syncthreads();
}

__device__ __forceinline__ void sgu_task(const Params& P, LAS unsigned char* lds, int task) {
    int tid_ = threadIdx.x; asm volatile("" : "+v"(tid_));
    const int tid = tid_, lane = tid & 63, wid = __builtin_amdgcn_readfirstlane(tid >> 6), fr = lane & 15, fq = lane >> 4;
    const int b = task >> 8, c = (task >> 2) & 63, g = task & 3, tok0 = b * SEQ + c * 128;
    unsigned char* ws = P.ws;
    LAS bf16_t* Wl = (LAS bf16_t*)lds; LAS bf16_t* Vst = (LAS bf16_t*)(lds + 32768);
    const bf16_t* p = (const bf16_t*)(ws + WS_P);
    f32x4 wa[4], wb[4]; u32x4 rv[4]; u32x2 ur[8];
#pragma unroll
    for (int it = 0; it < 4; ++it) { const int i = it * 512 + tid, t = i >> 4, sb = i & 15; const float* src = P.in[7] + (size_t)g * 16384 + t * 128 + sb * 8; wa[it] = *(const f32x4*)src; wb[it] = *(const f32x4*)(src + 4); }
#pragma unroll
    for (int it = 0; it < 4; ++it) { const int l = it * 32 + wid * 4 + (lane & 3), ch = lane >> 2; rv[it] = *(const u32x4*)(p + (size_t)(tok0 + l) * NP + 2560 + g * 128 + ch * 8); }
    { const bf16_t* up = p + (size_t)(tok0 + wid * 16 + fr) * NP + 2048 + g * 128 + fq * 4;
#pragma unroll
      for (int n = 0; n < 8; ++n) ur[n] = *(const u32x2*)(up + n * 16); }
    const float bsp = P.in[8][g * 128 + wid * 16 + fr];
#pragma unroll
    for (int it = 0; it < 4; ++it) {
        const int i = it * 512 + tid, t = i >> 4, sb = i & 15, s0 = sb * 8;
        float v[8] = {wa[it][0], wa[it][1], wa[it][2], wa[it][3], wb[it][0], wb[it][1], wb[it][2], wb[it][3]};
#pragma unroll
        for (int e = 0; e < 8; ++e) v[e] = (s0 + e <= t) ? v[e] : 0.f;
        u32x4 w; w.x = cvt_pk_bf16(v[0], v[1]); w.y = cvt_pk_bf16(v[2], v[3]); w.z = cvt_pk_bf16(v[4], v[5]); w.w = cvt_pk_bf16(v[6], v[7]);
        *(LAS u32x4*)(Wl + swz(t, s0)) = w;
    }
    { const int ch = lane >> 2; const float* nwp = P.in[5] + g * 128 + ch * 8; const float* nbp = P.in[6] + g * 128 + ch * 8;
      const f32x4 nw0 = *(const f32x4*)nwp, nw1 = *(const f32x4*)(nwp + 4), nb0 = *(const f32x4*)nbp, nb1 = *(const f32x4*)(nbp + 4);
      const float nw[8] = {nw0[0], nw0[1], nw0[2], nw0[3], nw1[0], nw1[1], nw1[2], nw1[3]}; const float nb[8] = {nb0[0], nb0[1], nb0[2], nb0[3], nb1[0], nb1[1], nb1[2], nb1[3]};
#pragma unroll
      for (int it = 0; it < 4; ++it) {
        const int l = it * 32 + wid * 4 + (lane & 3);
        float x[8]; unpack8(rv[it], x);
        float s = ((x[0] + x[1]) + (x[2] + x[3])) + ((x[4] + x[5]) + (x[6] + x[7]));
        s += __shfl_xor(s, 4); s += __shfl_xor(s, 8); s += __shfl_xor(s, 16); s += __shfl_xor(s, 32);
        const float mu = s * (1.f / 128.f); float q = 0.f;
#pragma unroll
        for (int e = 0; e < 8; ++e) { x[e] -= mu; q += x[e] * x[e]; }
        q += __shfl_xor(q, 4); q += __shfl_xor(q, 8); q += __shfl_xor(q, 16); q += __shfl_xor(q, 32);
        const float rstd = rsqrtf(q * (1.f / 128.f) + LN_EPS);
#pragma unroll
        for (int e = 0; e < 8; ++e) Vst[swz(ch * 8 + e, l)] = f2bf(x[e] * rstd * nw[e] + nb[e]);
      } }
    __syncthreads();
    f32x4 acc[8];
#pragma unroll
    for (int n = 0; n < 8; ++n) acc[n] = (f32x4){0.f, 0.f, 0.f, 0.f};
    wave_mm(Wl, Vst, acc, wid * 16, fr, fq, (wid >> 1) + 1, 8);
    { const int t = wid * 16 + fr, tok = tok0 + t;
      bf16_t* yp = (bf16_t*)(ws + WS_Y) + (size_t)tok * DM + 512 + g * 128 + fq * 4;
#pragma unroll
      for (int n = 0; n < 8; ++n) {
          u32x2 w; w.x = cvt_pk_bf16(bflo(ur[n].x) * (acc[n][0] + bsp), bfhi(ur[n].x) * (acc[n][1] + bsp)); w.y = cvt_pk_bf16(bflo(ur[n].y) * (acc[n][2] + bsp), bfhi(ur[n].y) * (acc[n][3] + bsp));
          *(u32x2*)(yp + n * 16) = w; } }
    __syncthreads();
}

__device__ __forceinline__ void phase_scan(const Params& P) {
    unsigned char* ws = P.ws;
    const float* __restrict__ gt = (const float*)(ws + WS_SMALL + SM_GTOT); const float* __restrict__ ml = (const float*)(ws + WS_SMALL + SM_MLOC);
    const float* __restrict__ dC = (const float*)(ws + WS_DC); unsigned* __restrict__ Cp = (unsigned*)(ws + WS_CPREV);
    for (int idx = blockIdx.x * 512 + threadIdx.x; idx < 8 * 8192; idx += gridDim.x * 512) {
        const int bh = idx >> 13, e = (idx & 8191) * 2;
        float m = 0.f, c0 = 0.f, c1 = 0.f;
#pragma unroll 1
        for (int cb = 0; cb < 64; cb += 16) {
            f32x2 d[16]; float g[16], l[16];
#pragma unroll
            for (int i = 0; i < 16; ++i) { const int task = bh * 64 + cb + i; d[i] = *(const f32x2*)(dC + (size_t)task * 16384 + e); g[i] = gt[task]; l[i] = ml[task]; }
#pragma unroll
            for (int i = 0; i < 16; ++i) { const int task = bh * 64 + cb + i;
                Cp[((size_t)task * 16384 + e) >> 1] = cvt_pk_bf16(c0, c1);
                const float mn = fmaxf(g[i] + m, l[i]), dec = __expf(g[i] + m - mn), sc = __expf(l[i] - mn);
                c0 = dec * c0 + sc * d[i].x; c1 = dec * c1 + sc * d[i].y; m = mn; }
        }
    }
    const float* __restrict__ dn = (const float*)(ws + WS_SMALL + SM_DN); float* __restrict__ np = (float*)(ws + WS_SMALL + SM_NPREV); float* __restrict__ mp = (float*)(ws + WS_SMALL + SM_MPREV);
    for (int idx = blockIdx.x * 512 + threadIdx.x; idx < 8 * 128; idx += gridDim.x * 512) {
        const int bh = idx >> 7, k = idx & 127;
        float m = 0.f, n = 0.f;
#pragma unroll 1
        for (int cb = 0; cb < 64; cb += 16) {
            float d[16], g[16], l[16];
#pragma unroll
            for (int i = 0; i < 16; ++i) { const int task = bh * 64 + cb + i; d[i] = dn[task * 128 + k]; g[i] = gt[task]; l[i] = ml[task]; }
#pragma unroll
            for (int i = 0; i < 16; ++i) { const int task = bh * 64 + cb + i;
                np[task * 128 + k] = n; if (k == 0) mp[task] = m;
                const float mn = fmaxf(g[i] + m, l[i]), dec = __expf(g[i] + m - mn), sc = __expf(l[i] - mn);
                n = dec * n + sc * d[i]; m = mn; }
        }
    }
}

__device__ __forceinline__ void mlstm_out(const Params& P, LAS unsigned char* lds, int task) {
    int tid_ = threadIdx.x; asm volatile("" : "+v"(tid_));
    const int tid = tid_, lane = tid & 63, wid = __builtin_amdgcn_readfirstlane(tid >> 6), fr = lane & 15, fq = lane >> 4;
    const int bh = task >> 6, c = task & 63, b = bh >> 2, h = bh & 3, tok0 = b * SEQ + c * 128;
    unsigned char* ws = P.ws;
    LAS bf16_t* Ql = (LAS bf16_t*)lds; LAS bf16_t* Kl = (LAS bf16_t*)(lds + 32768); LAS bf16_t* Vt = (LAS bf16_t*)(lds + 65536); LAS bf16_t* Cl = (LAS bf16_t*)(lds + 98304);
    LAS float* ibl = (LAS float*)(lds + 131072); LAS float* mjl = ibl + 128; LAS float* al = ibl + 256; LAS float* rcl = ibl + 384; LAS float* nl = ibl + 512;
    const float* gates = (const float*)(ws + WS_GATES); const bf16_t* p = (const bf16_t*)(ws + WS_P);
#ifdef REP_LOAD4
    for (int rl_ = 0; rl_ < REP_LOAD4; ++rl_) { asm volatile("" ::: "memory");
#else
    {
#endif
    float gi0 = 0.f, gi1 = 0.f, gf0 = 0.f, gf1 = 0.f, mprev = 0.f, n0v = 0.f, n1v = 0.f;
    if (wid == 0) { const int l0 = 2 * lane; gi0 = gates[(size_t)(tok0 + l0) * 8 + h]; gi1 = gates[(size_t)(tok0 + l0 + 1) * 8 + h]; gf0 = gates[(size_t)(tok0 + l0) * 8 + 4 + h]; gf1 = gates[(size_t)(tok0 + l0 + 1) * 8 + 4 + h];
        mprev = ((const float*)(ws + WS_SMALL + SM_MPREV))[task]; }
    else if (wid == 1) { n0v = ((const float*)(ws + WS_SMALL + SM_NPREV))[task * 128 + lane]; n1v = ((const float*)(ws + WS_SMALL + SM_NPREV))[task * 128 + lane + 64]; }
    u32x4 rq[4], rk[4], rv[4], rcv[4];
#pragma unroll
    for (int it = 0; it < 4; ++it) { const int i = it * 512 + tid, l = i >> 4, cb = i & 15;
        rq[it] = *(const u32x4*)((const bf16_t*)(ws + WS_QC) + (size_t)(tok0 + l) * 512 + h * 128 + cb * 8);
        rk[it] = *(const u32x4*)((const bf16_t*)(ws + WS_KC) + (size_t)(tok0 + l) * 512 + h * 128 + cb * 8);
        rcv[it] = *(const u32x4*)((const bf16_t*)(ws + WS_CPREV) + (size_t)task * 16384 + l * 128 + cb * 8); }
#pragma unroll
    for (int it = 0; it < 4; ++it) { const int l = it * 32 + wid * 4 + (lane & 3), ch = lane >> 2; rv[it] = *(const u32x4*)(p + (size_t)(tok0 + l) * NP + 1024 + h * 128 + ch * 8); }
    if (wid == 0) {
        const int l0 = 2 * lane;
        const float lf0 = logsigmoid(gf0), lf1 = logsigmoid(gf1);
        const float s1 = lf0 + lf1; float tot = s1;
#pragma unroll
        for (int o = 1; o < 64; o <<= 1) { const float t = __shfl_up(tot, o); if (lane >= o) tot += t; }
        const float ex = tot - s1, b0 = ex + lf0, b1 = ex + s1;
        const float ib0 = gi0 - b0, ib1 = gi1 - b1; const float pl = fmaxf(ib0, ib1); float pm = pl;
#pragma unroll
        for (int o = 1; o < 64; o <<= 1) { const float t = __shfl_up(pm, o); if (lane >= o) pm = fmaxf(pm, t); }
        float pex = __shfl_up(pm, 1); if (lane == 0) pex = -INFINITY;
        const float pm0 = fmaxf(pex, ib0), pm1 = fmaxf(pex, pl);
        const float mj0 = b0 + fmaxf(mprev, pm0), mj1 = b1 + fmaxf(mprev, pm1);
        const float L2E = 1.4426950408889634f;
        ibl[l0] = ib0 * L2E; ibl[l0 + 1] = ib1 * L2E; mjl[l0] = mj0; mjl[l0 + 1] = mj1;
        al[l0] = __expf(b0 + mprev - mj0); al[l0 + 1] = __expf(b1 + mprev - mj1); rcl[l0] = (b0 - mj0) * L2E; rcl[l0 + 1] = (b1 - mj1) * L2E;
    } else if (wid == 1) { nl[lane] = n0v; nl[lane + 64] = n1v; }
#pragma unroll
    for (int it = 0; it < 4; ++it) { const int i = it * 512 + tid, l = i >> 4, cb = i & 15;
        *(LAS u32x4*)(Ql + swz(l, cb * 8)) = rq[it]; *(LAS u32x4*)(Kl + swz(l, cb * 8)) = rk[it]; *(LAS u32x4*)(Cl + swz(l, cb * 8)) = rcv[it]; }
#pragma unroll
    for (int it = 0; it < 4; ++it) { const int l = it * 32 + wid * 4 + (lane & 3), ch = lane >> 2; VT_WRITE8(Vt, rv[it], ch, l); }
    __syncthreads();
    }
    const int l = wid * 16 + fr;
    u32x2 og[8];
    { const bf16_t* ogp = p + (size_t)(tok0 + l) * NP + 1536 + h * 128 + fq * 4;
#pragma unroll
      for (int n = 0; n < 8; ++n) og[n] = *(const u32x2*)(ogp + n * 16); }
    f32x4 acc[8];
#pragma unroll
    for (int n = 0; n < 8; ++n) acc[n] = (f32x4){0.f, 0.f, 0.f, 0.f};
    wave_mm(Ql, Kl, acc, wid * 16, fr, fq, 4, wid + 1);
    const float rc = rcl[l];
    float rs = 0.f;
#pragma unroll
    for (int n = 0; n < 8; ++n) {
        if (n < wid) { const f32x4 ib4 = *(const LAS f32x4*)(ibl + n * 16 + fq * 4);
#pragma unroll
            for (int j = 0; j < 4; ++j) { const float v = acc[n][j] * __builtin_amdgcn_exp2f(rc + ib4[j]); acc[n][j] = v; rs += v; } }
        else if (n == wid) { const f32x4 ib4 = *(const LAS f32x4*)(ibl + n * 16 + fq * 4);
#pragma unroll
            for (int j = 0; j < 4; ++j) { const int s = n * 16 + fq * 4 + j; const float w = (s <= l) ? __builtin_amdgcn_exp2f(rc + ib4[j]) : 0.f; const float v = acc[n][j] * w; acc[n][j] = v; rs += v; } }
    }
    rs += __shfl_xor(rs, 16); rs += __shfl_xor(rs, 32);
    float nq = 0.f;
#pragma unroll
    for (int blk = 0; blk < 4; ++blk) { const int kb = fq * 4 + blk; const u32x4 r = *(const LAS u32x4*)(Ql + swz(l, kb * 8)); float x[8]; unpack8(r, x);
#pragma unroll
        for (int e = 0; e < 8; ++e) nq += x[e] * nl[kb * 8 + e]; }
    nq += __shfl_xor(nq, 16); nq += __shfl_xor(nq, 32);
    __syncthreads();
#pragma unroll
    for (int n = 0; n < 8; ++n) { u32x2 w; w.x = cvt_pk_bf16(acc[n][0], acc[n][1]); w.y = cvt_pk_bf16(acc[n][2], acc[n][3]); *(LAS u32x2*)(Kl + swz(l, n * 16 + fq * 4)) = w; }
    __syncthreads();
    const float a = al[l], mj = mjl[l];
#pragma unroll
    for (int n = 0; n < 8; ++n) acc[n] = (f32x4){0.f, 0.f, 0.f, 0.f};
    wave_mm(Ql, Cl, acc, wid * 16, fr, fq, 4, 8);
#pragma unroll
    for (int n = 0; n < 8; ++n) acc[n] *= a;
    wave_mm(Kl, Vt, acc, wid * 16, fr, fq, (wid >> 1) + 1, 8);
    const float den = rs + a * nq, hd = fmaxf(fabsf(den), __expf(-mj)), inv = 1.f / hd;
    float sum = 0.f;
#pragma unroll
    for (int n = 0; n < 8; ++n) { acc[n] *= inv; sum += (acc[n][0] + acc[n][1]) + (acc[n][2] + acc[n][3]); }
    sum += __shfl_xor(sum, 16); sum += __shfl_xor(sum, 32);
    const float mu = sum * (1.f / 128.f); float q = 0.f;
#pragma unroll
    for (int n = 0; n < 8; ++n) { acc[n] -= mu; q += (acc[n][0] * acc[n][0] + acc[n][1] * acc[n][1]) + (acc[n][2] * acc[n][2] + acc[n][3] * acc[n][3]); }
    q += __shfl_xor(q, 16); q += __shfl_xor(q, 32);
    const float rstd = rsqrtf(q * (1.f / 128.f) + LN_EPS);
    { const int tok = tok0 + l; const float* nw = P.in[4] + h * 128 + fq * 4;
      bf16_t* yp = (bf16_t*)(ws + WS_Y) + (size_t)tok * DM + h * 128 + fq * 4;
#pragma unroll
      for (int n = 0; n < 8; ++n) { const u32x2 orw = og[n]; const f32x4 w4 = *(const f32x4*)(nw + n * 16);
          const float o0 = sigmf(bflo(orw.x)), o1 = sigmf(bfhi(orw.x)), o2 = sigmf(bflo(orw.y)), o3 = sigmf(bfhi(orw.y));
          u32x2 w; w.x = cvt_pk_bf16(o0 * acc[n][0] * rstd * w4[0], o1 * acc[n][1] * rstd * w4[1]); w.y = cvt_pk_bf16(o2 * acc[n][2] * rstd * w4[2], o3 * acc[n][3] * rstd * w4[3]);
          *(u32x2*)(yp + n * 16) = w; } }
    __syncthreads();
}

__device__ __forceinline__ void phase_ln(const float* in, float* outf, bf16_t* outb, float* stats, const float* w, const float* bsrc) {
    const int lane = threadIdx.x & 63, wid = threadIdx.x >> 6;
    f32x4 wv[4], bv[4];
#pragma unroll
    for (int i = 0; i < 4; ++i) { wv[i] = *(const f32x4*)(w + (i * 64 + lane) * 4); bv[i] = *(const f32x4*)(bsrc + (i * 64 + lane) * 4); }
    int row = blockIdx.x * 8 + wid; const int rstep = gridDim.x * 8; f32x4 nv[4];
    if (row < T_TOK) {
#pragma unroll
        for (int i = 0; i < 4; ++i) nv[i] = ((const f32x4*)(in + (size_t)row * DM))[i * 64 + lane]; }
    for (; row < T_TOK; row += rstep) {
        f32x4 v[4]; float s = 0.f;
#pragma unroll
        for (int i = 0; i < 4; ++i) v[i] = nv[i];
        if (row + rstep < T_TOK) {
#pragma unroll
            for (int i = 0; i < 4; ++i) nv[i] = ((const f32x4*)(in + (size_t)(row + rstep) * DM))[i * 64 + lane]; }
#pragma unroll
        for (int i = 0; i < 4; ++i) s += (v[i][0] + v[i][1]) + (v[i][2] + v[i][3]);
#pragma unroll
        for (int o = 32; o >= 1; o >>= 1) s += __shfl_xor(s, o);
        const float mu = s * (1.f / 1024.f); float q = 0.f;
#pragma unroll
        for (int i = 0; i < 4; ++i) { v[i] -= mu; q += (v[i][0] * v[i][0] + v[i][1] * v[i][1]) + (v[i][2] * v[i][2] + v[i][3] * v[i][3]); }
#pragma unroll
        for (int o = 32; o >= 1; o >>= 1) q += __shfl_xor(q, o);
        const float rstd = rsqrtf(q * (1.f / 1024.f) + LN_EPS);
        if (stats && lane == 0) { f32x2 st; st.x = mu; st.y = rstd; *(f32x2*)(stats + (size_t)row * 2) = st; }
#pragma unroll
        for (int i = 0; i < 4; ++i) { const f32x4 y = v[i] * rstd * wv[i] + bv[i];
            if (outf) *(f32x4*)(outf + (size_t)row * DM + (i * 64 + lane) * 4) = y;
            if (outb) { u32x2 pk; pk.x = cvt_pk_bf16(y[0], y[1]); pk.y = cvt_pk_bf16(y[2], y[3]); *(u32x2*)(outb + (size_t)row * DM + (i * 64 + lane) * 4) = pk; } }
    }
}

#ifndef GEMM_ALIGN
#define GEMM_ALIGN true
#endif
#ifndef GEMM_SP2
#define GEMM_SP2 true
#endif
#ifndef REP_G1
#define REP_G1 1
#endif
#ifndef REP_G2
#define REP_G2 1
#endif
#ifndef REP_G3
#define REP_G3 1
#endif
#ifndef REP_G4
#define REP_G4 1
#endif
#ifndef REP_LN
#define REP_LN 0
#endif
#ifndef REP_ML
#define REP_ML 1
#endif
#ifndef REP_SGU
#define REP_SGU 1
#endif
#ifndef REP_PREP
#define REP_PREP 1
#endif
#ifndef REP_P2
#define REP_P2 1
#endif
#ifndef REP_P3
#define REP_P3 1
#endif
#ifndef REP_P4
#define REP_P4 1
#endif
__global__ void __launch_bounds__(512, 2) fwd_megakernel(Params P) {
    extern __shared__ __attribute__((aligned(16))) unsigned char shm[];
    LAS unsigned char* lds = (LAS unsigned char*)shm;
    cg::grid_group grid = cg::this_grid();
    unsigned char* ws = P.ws;
    const int G = (int)gridDim.x, bx = (int)blockIdx.x;
    volatile LAS unsigned* xst = (volatile LAS unsigned*)(lds + LDS_BYTES - 16);
    if (threadIdx.x < 4) xst[threadIdx.x] = 0u;
    __syncthreads();
    const bool use_cg = G > 1024;
    XcdBarrier xbar = xcd_barrier_post((unsigned*)(ws + WS_BAR), xst);
#define GRID_SEAM() do { if (use_cg) grid.sync(); else xcd_barrier(xbar); } while (0)

    for (int rep = 0; rep < REP_PREP; ++rep) { phase_prep(P, lds); GRID_SEAM(); }
    for (int rep = 0; rep < REP_G1; ++rep) {
    { pg8::Gemm g{(const bf16_t*)(ws + WS_XB), (const bf16_t*)(ws + WS_WINT), T_TOK, NP, DM}; pg8::StaticOrder S; S.init(T_TOK, NP, G, bx); EpiP E{(bf16_t*)(ws + WS_P)};
      pg8::gemm_phase<EpiP, pg8::StaticOrder, GEMM_ALIGN, GEMM_SP2>(lds, g, S, E); }
    GRID_SEAM();
    }
    for (int rep = 0; rep < REP_P2; ++rep) { for (int task = bx; task < 1024; task += G) { if (task < 512) { for (int r2 = 0; r2 < REP_ML; ++r2) mlstm_local(P, lds, task); } else { for (int r2 = 0; r2 < REP_SGU; ++r2) sgu_task(P, lds, task - 512); } }
    GRID_SEAM(); }
    for (int rep = 0; rep < REP_P3; ++rep) { phase_scan(P); wt_phase(P, lds, 384, 1568); GRID_SEAM(); }
    for (int rep = 0; rep < REP_P4; ++rep) { for (int task = bx; task < 512; task += G) mlstm_out(P, lds, task);
    GRID_SEAM(); }
    for (int rep = 0; rep < REP_G2; ++rep) {
    { pg8::Gemm g{(const bf16_t*)(ws + WS_Y), (const bf16_t*)(ws + WS_WOUTT), T_TOK, DM, DM}; pg8::StaticOrder S; S.init(T_TOK, DM, G, bx); EpiRes E{(float*)(ws + WS_R1), P.in[0]};
      pg8::gemm_phase<EpiRes, pg8::StaticOrder, GEMM_ALIGN, GEMM_SP2>(lds, g, S, E); }
    GRID_SEAM();
    }
    for (int rep = 0; rep < REP_LN; ++rep) { phase_ln((const float*)(ws + WS_R1), nullptr, (bf16_t*)(ws + WS_HDN + 64 * MiB), (float*)(ws + WS_HDN), P.in[10], P.in[11]); GRID_SEAM(); }
    phase_ln((const float*)(ws + WS_R1), nullptr, (bf16_t*)(ws + WS_H1B), (float*)(ws + WS_SMALL + SM_STATS), P.in[10], P.in[11]);
    GRID_SEAM();
    for (int rep = 0; rep < REP_G3; ++rep) {
    { pg8::Gemm g{(const bf16_t*)(ws + WS_H1B), (const bf16_t*)(ws + WS_WGUT), T_TOK, 2 * DFF, DM}; pg8::StaticOrder S; S.init(T_TOK, 2 * DFF, G, bx); EpiSwiglu E{(bf16_t*)(ws + WS_HDN)};
      pg8::gemm_phase<EpiSwiglu, pg8::StaticOrder, GEMM_ALIGN, GEMM_SP2>(lds, g, S, E); }
    GRID_SEAM();
    }
    for (int rep = 0; rep < REP_G4; ++rep) {
    { pg8::Gemm g{(const bf16_t*)(ws + WS_HDN), (const bf16_t*)(ws + WS_WDOWNT), T_TOK, DM, DFF}; pg8::StaticOrder S; S.init(T_TOK, DM, G, bx); EpiResLn E{P.out, (const float*)(ws + WS_R1), (const float*)(ws + WS_SMALL + SM_STATS), P.in[10], P.in[11]};
      pg8::gemm_phase<EpiResLn, pg8::StaticOrder, GEMM_ALIGN, GEMM_SP2>(lds, g, S, E); }
    GRID_SEAM();
    }
    phase_ln(P.out, P.out, nullptr, nullptr, P.in[15], P.in[16]);
#ifdef REP_SYNC
    for (int rep = 0; rep < REP_SYNC; ++rep) GRID_SEAM();
#endif
}

extern "C" void kernel_launch(void* const* d_in, const int* in_sizes, int n_in, void* d_out, int out_size, void* d_ws, size_t ws_size, hipStream_t stream) {
    (void)in_sizes; (void)n_in; (void)out_size; (void)ws_size;
    static int grid_blocks = 0;
    if (!grid_blocks) {
        int dev = 0, cus = 0, per_cu = 0;
        hipGetDevice(&dev);
        hipDeviceGetAttribute(&cus, hipDeviceAttributeMultiprocessorCount, dev);
        if (hipFuncSetAttribute((const void*)fwd_megakernel, hipFuncAttributeMaxDynamicSharedMemorySize, LDS_BYTES) != hipSuccess) fprintf(stderr, "hipFuncSetAttribute failed\n");
        if (hipOccupancyMaxActiveBlocksPerMultiprocessor(&per_cu, (const void*)fwd_megakernel, 512, LDS_BYTES) != hipSuccess || per_cu < 1) { fprintf(stderr, "occupancy query failed\n"); per_cu = 1; }
        if (per_cu > 1) per_cu = 1;
        grid_blocks = cus * per_cu;
    }
    Params P{};
    for (int i = 0; i < 17; ++i) P.in[i] = (const float*)d_in[i];
    P.out = (float*)d_out; P.ws = (unsigned char*)d_ws;
    hipMemsetAsync((unsigned char*)d_ws + WS_BAR, 0, XCD_BAR_WORDS * sizeof(unsigned), stream);
    void* args[] = {&P};
    hipError_t e = hipLaunchCooperativeKernel((const void*)fwd_megakernel, dim3(grid_blocks), dim3(512), args, LDS_BYTES, stream);
    if (e != hipSuccess) fprintf(stderr, "cooperative launch failed: %s (grid %d)\n", hipGetErrorString(e), grid_blocks);
}
```
